# Optimizing an MI355X kernel written in HIP

```python
import math
import jax, jax.numpy as jnp
from jax import lax
import numpy as np

D_MODEL = 4096
BATCH = 2
SEQ = 8192
DEPTH = 1

PLE_DIM = 256
HEAD_DIM = 128
N_HEADS = D_MODEL // 256
V_HEAD_DIM = 2 * HEAD_DIM
D_QK = N_HEADS * 2 * HEAD_DIM
D_ATTN = N_HEADS * V_HEAD_DIM
Q_BLOCK = 128
D_GMLP = D_MODEL
GMLP_GROUPS = 16
GROUP_DIM = D_GMLP // GMLP_GROUPS
CHUNK = 128
D_FF = -(-8 * D_MODEL // (3 * 256)) * 256
IN_SIZES = (D_GMLP, D_GMLP, D_QK, D_QK, D_ATTN, D_MODEL, D_MODEL)
IN_TOTAL = 2 * D_GMLP + 2 * D_QK + D_ATTN + 2 * D_MODEL
RMS_EPS = 1e-6
LN_EPS = 1e-5

kernel_name = "hybrid_gmlp_diffattn_gated_block"


def _rmsnorm(x, g, eps=RMS_EPS):
    xf = x.astype(jnp.float32)
    y = xf * lax.rsqrt(jnp.mean(xf * xf, axis=-1, keepdims=True) + eps)
    return (y * g.astype(jnp.float32)).astype(x.dtype)


def _layernorm(x, g, b, eps=LN_EPS):
    xf = x.astype(jnp.float32)
    mu = jnp.mean(xf, axis=-1, keepdims=True)
    xc = xf - mu
    var = jnp.mean(xc * xc, axis=-1, keepdims=True)
    y = xc * lax.rsqrt(var + eps) * g.astype(jnp.float32) + b.astype(jnp.float32)
    return y.astype(x.dtype)


def _alibi_slopes(n_heads):
    return jnp.exp2(-8.0 * jnp.arange(1, n_heads + 1, dtype=jnp.float32) / n_heads)


def _spatial_gating(u, v, w_s, b_s, ln_g, ln_b):
    bsz, s, _ = v.shape
    n_chunks = s // CHUNK
    vn = _layernorm(v, ln_g, ln_b).reshape(bsz, n_chunks, CHUNK, GMLP_GROUPS, GROUP_DIM)
    causal = jnp.tril(jnp.ones((CHUNK, CHUNK), dtype=w_s.dtype))
    w = w_s * causal
    mixed = jnp.einsum('gts,bcsgd->bctgd', w, vn) + b_s.T[:, :, None]
    return u * mixed.reshape(bsz, s, D_GMLP)


def _diff_attention(q, k, v, lam, slopes):
    bsz, s = q.shape[0], q.shape[1]
    n_blocks = s // Q_BLOCK
    scale = HEAD_DIM ** -0.5
    k_pos = jnp.arange(s)

    def block(i):
        start = i * Q_BLOCK
        qb = lax.dynamic_slice_in_dim(q, start, Q_BLOCK, axis=1)
        scores = jnp.einsum('bqhmd,bkhmd->bhmqk', qb, k,
                            preferred_element_type=jnp.float32) * scale
        q_pos = start + jnp.arange(Q_BLOCK)
        dist = (q_pos[:, None] - k_pos[None, :]).astype(jnp.float32)
        bias = -slopes[:, None, None, None] * dist
        scores = jnp.where(dist >= 0, scores + bias, -jnp.inf)
        probs = jax.nn.softmax(scores, axis=-1).astype(v.dtype)
        o = jnp.einsum('bhmqk,bkhe->bqhme', probs, v)
        return o[:, :, :, 0] - lam.astype(o.dtype) * o[:, :, :, 1]

    out = lax.map(block, jnp.arange(n_blocks))
    return out.transpose(1, 0, 2, 3, 4).reshape(bsz, s, N_HEADS, V_HEAD_DIM)


def setup_inputs(seed: int = 0) -> dict:
    key = jax.random.key(seed)
    ks = jax.random.split(key, 26)
    f32 = jnp.float32

    def nrm(k, shape, scale):
        return jax.random.normal(k, shape, f32) * scale

    L = DEPTH
    return {
        'x': nrm(ks[0], (BATCH, SEQ, D_MODEL), 1.0),
        'p': nrm(ks[1], (DEPTH, BATCH, SEQ, PLE_DIM), 1.0),
        'g_mix': 1.0 + nrm(ks[2], (L, D_MODEL), 0.02),
        'w_in': nrm(ks[3], (L, D_MODEL, IN_TOTAL), D_MODEL ** -0.5),
        'b_gate': nrm(ks[4], (L, 2, D_MODEL), 0.02),
        'ln_v_g': 1.0 + nrm(ks[5], (L, D_GMLP), 0.02),
        'ln_v_b': nrm(ks[6], (L, D_GMLP), 0.02),
        'w_s': nrm(ks[7], (L, GMLP_GROUPS, CHUNK, CHUNK), CHUNK ** -0.5),
        'b_s': nrm(ks[8], (L, GMLP_GROUPS, CHUNK), 0.02),
        'lambda_q1': nrm(ks[9], (L, HEAD_DIM), 0.1),
        'lambda_k1': nrm(ks[10], (L, HEAD_DIM), 0.1),
        'lambda_q2': nrm(ks[11], (L, HEAD_DIM), 0.1),
        'lambda_k2': nrm(ks[12], (L, HEAD_DIM), 0.1),
        'subln_g': 1.0 + nrm(ks[13], (L, V_HEAD_DIM), 0.02),
        'w_br_a': nrm(ks[14], (L, D_GMLP, D_MODEL), D_GMLP ** -0.5),
        'w_br_b': nrm(ks[15], (L, D_ATTN, D_MODEL), D_ATTN ** -0.5),
        'w_o': nrm(ks[16], (L, D_MODEL, D_MODEL), D_MODEL ** -0.5),
        'g_ffn': 1.0 + nrm(ks[17], (L, D_MODEL), 0.02),
        'w_gu': nrm(ks[18], (L, D_MODEL, 2 * D_FF), D_MODEL ** -0.5),
        'w_down': nrm(ks[19], (L, D_FF, D_MODEL), D_FF ** -0.5),
        'g_ple': 1.0 + nrm(ks[20], (L, D_MODEL), 0.02),
        'w_ple_gate': nrm(ks[21], (L, D_MODEL, D_MODEL), D_MODEL ** -0.5),
        'w_ple_proj': nrm(ks[22], (L, PLE_DIM, D_MODEL), PLE_DIM ** -0.5),
        'g_final': 1.0 + nrm(ks[23], (D_MODEL,), 0.02),
    }


def reference(x, p, g_mix, w_in, b_gate, ln_v_g, ln_v_b, w_s, b_s,
              lambda_q1, lambda_k1, lambda_q2, lambda_k2, subln_g,
              w_br_a, w_br_b, w_o, g_ffn, w_gu, w_down,
              g_ple, w_ple_gate, w_ple_proj, g_final):
    bsz, s, _ = x.shape
    split_points = np.cumsum(IN_SIZES)[:-1].tolist()
    slopes = _alibi_slopes(N_HEADS)
    for i in range(DEPTH):
        h = _rmsnorm(x, g_mix[i])
        proj = h @ w_in[i]
        u_a, v_a, q, k, v_b, gate_a, gate_b = jnp.split(proj, split_points, axis=-1)

        y_a = _spatial_gating(jax.nn.gelu(u_a, approximate=False),
                              jax.nn.gelu(v_a, approximate=False),
                              w_s[i], b_s[i], ln_v_g[i], ln_v_b[i])

        lam_init = 0.8 - 0.6 * math.exp(-0.3 * i)
        lam = (jnp.exp(jnp.sum(lambda_q1[i].astype(jnp.float32) * lambda_k1[i].astype(jnp.float32)))
               - jnp.exp(jnp.sum(lambda_q2[i].astype(jnp.float32) * lambda_k2[i].astype(jnp.float32)))
               + lam_init)
        qh = q.reshape(bsz, s, N_HEADS, 2, HEAD_DIM)
        kh = k.reshape(bsz, s, N_HEADS, 2, HEAD_DIM)
        vh = v_b.reshape(bsz, s, N_HEADS, V_HEAD_DIM)
        o = _diff_attention(qh, kh, vh, lam, slopes)
        y_b = (_rmsnorm(o, subln_g[i], eps=LN_EPS) * (1.0 - lam_init)).reshape(bsz, s, D_ATTN)

        merged = (jax.nn.sigmoid(gate_a + b_gate[i, 0]) * (y_a @ w_br_a[i])
                  + jax.nn.sigmoid(gate_b + b_gate[i, 1]) * (y_b @ w_br_b[i]))
        x = x + merged @ w_o[i]

        h = _rmsnorm(x, g_ffn[i])
        g_ff, u_ff = jnp.split(h @ w_gu[i], 2, axis=-1)
        x = x + (jax.nn.silu(g_ff) * u_ff) @ w_down[i]

        x = x + jax.nn.sigmoid(_rmsnorm(x, g_ple[i]) @ w_ple_gate[i]) * (p[i] @ w_ple_proj[i])
    return _rmsnorm(x, g_final)
```

```cpp
#include <hip/hip_runtime.h>
#include <cstdio>
#include <cstdint>

#ifndef PROBE_NULLEPI
#define PROBE_NULLEPI 0
#endif
#ifndef DBG_CHECK
#define DBG_CHECK 0
#endif

#define LAS __attribute__((address_space(3)))
#define GAS __attribute__((address_space(1)))
typedef unsigned short bf16_t;
typedef short bf16x8 __attribute__((ext_vector_type(8)));
typedef short s16x4 __attribute__((ext_vector_type(4)));
typedef float f32x4 __attribute__((ext_vector_type(4)));
typedef float f32x2 __attribute__((ext_vector_type(2)));
typedef float f32x16 __attribute__((ext_vector_type(16)));
typedef unsigned u32x4 __attribute__((ext_vector_type(4)));
typedef unsigned u32x2 __attribute__((ext_vector_type(2)));
typedef int i32x4 __attribute__((ext_vector_type(4)));
typedef int i32x8 __attribute__((ext_vector_type(8)));

constexpr int D_MODEL = 4096, BATCH = 2, SEQ = 8192, M_TOK = BATCH * SEQ;
constexpr int PLE_DIM = 256, HEAD_DIM = 128, N_HEADS = 16, V_HEAD_DIM = 256;
constexpr int D_FF = 11008, IN_TOTAL = 28672, CHUNK = 128, GROUPS = 16;
constexpr float RMS_EPS = 1e-6f, LN_EPS = 1e-5f, LAM_INIT = 0.2f;
constexpr float QSCALE = 0.08838834764831845f * 1.4426950408889634f;

typedef __bf16 bf16x2_t __attribute__((ext_vector_type(2)));
__device__ __forceinline__ unsigned cvt_pk_bf16(float lo, float hi) { const f32x2 v = {lo, hi}; const bf16x2_t r = __builtin_convertvector(v, bf16x2_t); return __builtin_bit_cast(unsigned, r); }
__device__ __forceinline__ unsigned pk_fp8x4(float a, float b, float c, float d) {
    a = __builtin_amdgcn_fmed3f(a, -448.f, 448.f); b = __builtin_amdgcn_fmed3f(b, -448.f, 448.f); c = __builtin_amdgcn_fmed3f(c, -448.f, 448.f); d = __builtin_amdgcn_fmed3f(d, -448.f, 448.f);
    int w = __builtin_amdgcn_cvt_pk_fp8_f32(a, b, 0, false); w = __builtin_amdgcn_cvt_pk_fp8_f32(c, d, w, true); return (unsigned)w; }
__device__ __forceinline__ unsigned pk_gate4(f32x4 v) {
    const f32x4 t = v * 255.f; unsigned w = 0u;
    w = __builtin_amdgcn_cvt_pk_u8_f32(fmaxf(t[0], 1.f), 0u, w); w = __builtin_amdgcn_cvt_pk_u8_f32(fmaxf(t[1], 1.f), 1u, w);
    w = __builtin_amdgcn_cvt_pk_u8_f32(fmaxf(t[2], 1.f), 2u, w); w = __builtin_amdgcn_cvt_pk_u8_f32(fmaxf(t[3], 1.f), 3u, w); return w; }
__device__ __forceinline__ f32x4 unpk_gate4(unsigned w) {
    return (f32x4){(float)(w & 0xffu), (float)((w >> 8) & 0xffu), (float)((w >> 16) & 0xffu), (float)(w >> 24)} * (1.f / 255.f); }
constexpr float F8_SA = 16.f, F8_SW = 1024.f, F8_DESC = 1.f / (16.f * 1024.f);
__device__ __forceinline__ float bf2f(unsigned short b) { return __uint_as_float(((unsigned)b) << 16); }
__device__ __forceinline__ float bflo(unsigned w) { return __uint_as_float(w << 16); }
__device__ __forceinline__ float bfhi(unsigned w) { return __uint_as_float(w & 0xffff0000u); }
template <int K> __device__ __forceinline__ float swz_xor(float v) { return __int_as_float(__builtin_amdgcn_ds_swizzle(__float_as_int(v), (K << 10) | 0x1f)); }
__device__ __forceinline__ float half_sum(float v) { v += swz_xor<1>(v); v += swz_xor<2>(v); v += swz_xor<4>(v); v += swz_xor<8>(v); v += swz_xor<16>(v); return v; }
__device__ __forceinline__ float wave_sum(float v) { v = half_sum(v); auto rr = __builtin_amdgcn_permlane32_swap(__float_as_uint(v), __float_as_uint(v), false, false); return __uint_as_float(rr[0]) + __uint_as_float(rr[1]); }
__device__ __forceinline__ float sgpr_f(float v) { return __uint_as_float(__builtin_amdgcn_readfirstlane(__float_as_uint(v))); }
__device__ __forceinline__ int lane_id() { int l; asm volatile("v_mbcnt_lo_u32_b32 %0, -1, 0\n\tv_mbcnt_hi_u32_b32 %0, -1, %0" : "=v"(l)); return l; }
__device__ __forceinline__ float sigm(float x) { return __builtin_amdgcn_rcpf(1.f + __builtin_amdgcn_exp2f(-1.4426950408889634f * x)); }

namespace pg8 {
constexpr int BM = 256, BK = 64, HALF = 128, HTB = HALF * BK * 2, STAGE_BYTES = 8 * HTB, NXCD = 8, WGM = 8;
__host__ __device__ __forceinline__ int lds_byte(int r, int c) { const int st = (r >> 4) * 2 + (c >> 5), rr = r & 15, cc = c & 31, ob = rr * 64 + cc * 2; return st * 1024 + (ob ^ (((ob >> 9) & 1) << 5)); }
__host__ __device__ __forceinline__ void stage_rc(int b, int& R, int& C) { const int st = b / 1024, sb = b % 1024, swz = sb ^ (((sb >> 9) & 1) << 5); R = (st >> 1) * 16 + swz / 64; C = (st & 1) * 32 + (swz % 64) / 2; }
__host__ __device__ __forceinline__ int perm32(int rho) { const int n = rho >> 4, i = rho & 15; return 8 * (i >> 2) + 4 * n + (i & 3); }

struct Unit { int pm, pn; };
struct Gemm { const bf16_t* A; const bf16_t* Bt; const bf16_t* A2; const bf16_t* Bt2; int M, N, K, ld, nt1; };

struct StaticOrder {
    int nM, nN, nwg, G, c;
    __host__ __device__ void init(int M, int N, int G_, int c_) { nM = M / BM; nN = N / BM; nwg = nM * nN; G = G_; c = c_; }
    __host__ __device__ bool next(int i, Unit& u) const {
        const long L = (long)i * G + c; if (L >= nwg) return false;
        int wgid = (int)L; { const int q = nwg / NXCD, r = nwg % NXCD, xcd = wgid % NXCD, off = wgid / NXCD; wgid = (xcd < r ? xcd * (q + 1) : r * (q + 1) + (xcd - r) * q) + off; }
        const int nig = WGM * nN, gid = wgid / nig, fm = gid * WGM, gsz = (nM - fm) < WGM ? (nM - fm) : WGM;
        u.pm = fm + ((wgid % nig) % gsz); u.pn = (wgid % nig) / gsz; return true;
    }
};

template <int PA> struct PanelOrder {
    int nM, G, c, NX;
    __host__ __device__ void init(int M, int G_, int c_) { nM = M / BM; G = G_; c = c_; NX = (G % NXCD == 0 && nM % NXCD == 0) ? NXCD : 1; }
    __host__ __device__ bool next(int i, Unit& u) const {
        const int per = G / NX, x = c % NX, r = c / NX, ppx = nM / NX;
        const int idx = i * per + r;
        const int blk = idx / (PA * 16), w = idx % (PA * 16), pl = blk * PA + w / 16;
        if (pl >= ppx) return false;
        u.pm = x * ppx + pl; u.pn = w % 16; return true;
    }
};
__device__ __forceinline__ f32x2 gelu_pk(f32x2 v) {
    const f32x2 av = __builtin_elementwise_abs(v), d = av * 0.2316418882f + 1.0f;
    f32x2 t; t.x = __builtin_amdgcn_rcpf(d.x); t.y = __builtin_amdgcn_rcpf(d.y);
    f32x2 q = t * 0.5307027145f + (-0.7265760135f); q = q * t + 0.7107068705f; q = q * t + (-0.142248368f); q = q * t + 0.127414796f; q = q * t;
    const f32x2 s = (v * v) * (-0.72134752044f);
    f32x2 e; e.x = __builtin_amdgcn_exp2f(s.x); e.y = __builtin_amdgcn_exp2f(s.y);
    const f32x2 m = v * (q * e), r = v - m;
    f32x2 o; o.x = v.x < 0.f ? m.x : r.x; o.y = v.y < 0.f ? m.y : r.y; return o;
}
__device__ __forceinline__ f32x4 gelu4(f32x4 v) { const f32x2 a = gelu_pk((f32x2){v[0], v[1]}), b = gelu_pk((f32x2){v[2], v[3]}); return (f32x4){a.x, a.y, b.x, b.y}; }
__device__ __forceinline__ f32x4 sigm4(f32x4 v) { return (f32x4){sigm(v[0]), sigm(v[1]), sigm(v[2]), sigm(v[3])}; }
__device__ __forceinline__ u32x4 pack8(f32x4 v0, f32x4 v1) { u32x4 w; w.x = cvt_pk_bf16(v0[0], v0[1]); w.y = cvt_pk_bf16(v0[2], v0[3]); w.z = cvt_pk_bf16(v1[0], v1[1]); w.w = cvt_pk_bf16(v1[2], v1[3]); return w; }
__device__ __forceinline__ void unpack8(u32x4 w, f32x4& v0, f32x4& v1) { v0 = (f32x4){bflo(w.x), bfhi(w.x), bflo(w.y), bfhi(w.y)}; v1 = (f32x4){bflo(w.z), bfhi(w.z), bflo(w.w), bfhi(w.w)}; }
__device__ __forceinline__ float hsum4(f32x4 v) { return (v[0] + v[1]) + (v[2] + v[3]); }
__device__ __forceinline__ float hsq4(f32x4 v) { return (v[0] * v[0] + v[1] * v[1]) + (v[2] * v[2] + v[3] * v[3]); }
__device__ __forceinline__ float row_rstd(const float* stat, int row, int fq, float eps) {
    const f32x4* p = (const f32x4*)(stat + (size_t)row * 64 + fq * 16);
    const f32x4 a = p[0], b = p[1], c = p[2], d = p[3];
    float s = (hsum4(a) + hsum4(b)) + (hsum4(c) + hsum4(d));
    s += __shfl_xor(s, 16); s += __shfl_xor(s, 32);
    return rsqrtf(s * (1.0f / D_MODEL) + eps);
}

struct EpiProj {
    static constexpr bool PERM = true, HAS_MID = false;
    bf16_t* O; float* statv; unsigned* kn;
    __device__ __forceinline__ void mid(f32x4 (&)[2][2][4][2], const Unit&, int, int, int, int) const {}
    __device__ __forceinline__ void operator()(const f32x4 (&acc)[2][2][4][2], const Unit& u, int wr, int wc, int fr, int fq) const {
        const int t = u.pn >> 4, ct = u.pn & 15;
        const int row0 = u.pm * BM + wr * 64 + fr, col0 = ct * BM + wc * 32 + 8 * fq;
        bf16_t* base = O + (size_t)t * ((size_t)M_TOK * D_MODEL);
        if (t == 1) {
#pragma unroll
            for (int ai = 0; ai < 2; ++ai)
#pragma unroll
                for (int m = 0; m < 4; ++m) { const int row = row0 + ai * HALF + m * 16; bf16_t* rowp = base + (size_t)row * D_MODEL + col0; float s = 0.f, ss = 0.f;
#pragma unroll
                    for (int bj = 0; bj < 2; ++bj) { const f32x4 v0 = gelu4(acc[ai][bj][m][0]), v1 = gelu4(acc[ai][bj][m][1]);
                        s += hsum4(v0) + hsum4(v1); ss += hsq4(v0) + hsq4(v1);
                        *(u32x4*)(rowp + bj * HALF) = pack8(v0, v1); }
                    s += __shfl_xor(s, 16); s += __shfl_xor(s, 32); ss += __shfl_xor(ss, 16); ss += __shfl_xor(ss, 32);
                    if (fq == 0) *(f32x2*)(statv + ((size_t)row * 64 + ct * 4 + wc) * 2) = (f32x2){s, ss}; }
        } else {
            const float sc = (t == 2) ? QSCALE : 1.f;
            if (t == 3) {
                float mx0 = 0.f, mx1 = 0.f;
#pragma unroll
                for (int ai = 0; ai < 2; ++ai)
#pragma unroll
                    for (int m = 0; m < 4; ++m) { float s0 = hsq4(acc[ai][0][m][0]) + hsq4(acc[ai][0][m][1]), s1 = hsq4(acc[ai][1][m][0]) + hsq4(acc[ai][1][m][1]);
                        s0 += __shfl_xor(s0, 16); s0 += __shfl_xor(s0, 32); s1 += __shfl_xor(s1, 16); s1 += __shfl_xor(s1, 32); mx0 = fmaxf(mx0, s0); mx1 = fmaxf(mx1, s1); }
                mx0 = fmaxf(mx0, swz_xor<1>(mx0)); mx0 = fmaxf(mx0, swz_xor<2>(mx0)); mx0 = fmaxf(mx0, swz_xor<4>(mx0)); mx0 = fmaxf(mx0, swz_xor<8>(mx0));
                mx1 = fmaxf(mx1, swz_xor<1>(mx1)); mx1 = fmaxf(mx1, swz_xor<2>(mx1)); mx1 = fmaxf(mx1, swz_xor<4>(mx1)); mx1 = fmaxf(mx1, swz_xor<8>(mx1));
                if (fr == 0 && fq == 0) { unsigned* kp = kn + (((u.pm >> 5) * 16 + ct) * 2) * 4 + wc; atomicMax(kp, __float_as_uint(mx0)); atomicMax(kp + 4, __float_as_uint(mx1)); }
            }
#pragma unroll
            for (int ai = 0; ai < 2; ++ai)
#pragma unroll
                for (int m = 0; m < 4; ++m) { bf16_t* rowp = base + (size_t)(row0 + ai * HALF + m * 16) * D_MODEL + col0;
#pragma unroll
                    for (int bj = 0; bj < 2; ++bj) *(u32x4*)(rowp + bj * HALF) = pack8(acc[ai][bj][m][0] * sc, acc[ai][bj][m][1] * sc); }
        }
    }
};
struct EpiGates {
    static constexpr bool PERM = true, HAS_MID = false;
    bf16_t* O; const float* bgate;
    __device__ __forceinline__ void mid(f32x4 (&)[2][2][4][2], const Unit&, int, int, int, int) const {}
    __device__ __forceinline__ void operator()(const f32x4 (&acc)[2][2][4][2], const Unit& u, int wr, int wc, int fr, int fq) const {
        const int row0 = u.pm * BM + wr * 64 + fr, col0 = u.pn * HALF + wc * 32 + 8 * fq;
        bf16_t* RA = O + (size_t)5 * ((size_t)M_TOK * D_MODEL); unsigned char* SBo = (unsigned char*)(O + (size_t)6 * ((size_t)M_TOK * D_MODEL));
        const f32x4 a0 = *(const f32x4*)(bgate + col0), a1 = *(const f32x4*)(bgate + col0 + 4), b0 = *(const f32x4*)(bgate + D_MODEL + col0), b1 = *(const f32x4*)(bgate + D_MODEL + col0 + 4);
#pragma unroll
        for (int ai = 0; ai < 2; ++ai)
#pragma unroll
            for (int m = 0; m < 4; ++m) { const size_t off = (size_t)(row0 + ai * HALF + m * 16) * D_MODEL + col0;
                f32x4 r0, r1, s0, s1;
#pragma unroll
                for (int j = 0; j < 4; ++j) {
                    const float ea0 = 1.f + __builtin_amdgcn_exp2f(-1.4426950408889634f * (acc[ai][0][m][0][j] * F8_DESC + a0[j])), ea1 = 1.f + __builtin_amdgcn_exp2f(-1.4426950408889634f * (acc[ai][0][m][1][j] * F8_DESC + a1[j]));
                    const float eb0 = 1.f + __builtin_amdgcn_exp2f(-1.4426950408889634f * (acc[ai][1][m][0][j] * F8_DESC + b0[j])), eb1 = 1.f + __builtin_amdgcn_exp2f(-1.4426950408889634f * (acc[ai][1][m][1][j] * F8_DESC + b1[j]));
                    r0[j] = eb0 * __builtin_amdgcn_rcpf(ea0); r1[j] = eb1 * __builtin_amdgcn_rcpf(ea1); s0[j] = __builtin_amdgcn_rcpf(eb0); s1[j] = __builtin_amdgcn_rcpf(eb1); }
                *(u32x4*)(RA + off) = pack8(r0, r1); *(u32x2*)(SBo + off) = (u32x2){pk_gate4(s0), pk_gate4(s1)}; }
    }
};
template <int MODE> struct EpiProbe {
    static constexpr bool PERM = true, HAS_MID = false;
    bf16_t* O;
    __device__ __forceinline__ void mid(f32x4 (&)[2][2][4][2], const Unit&, int, int, int, int) const {}
    __device__ __forceinline__ void operator()(const f32x4 (&acc)[2][2][4][2], const Unit& u, int wr, int wc, int fr, int fq) const {
        const int t = u.pn >> 4, ct = u.pn & 15;
        const int row0 = u.pm * BM + wr * 64 + fr, col0 = ct * BM + wc * 32 + 8 * fq;
        bf16_t* base = O + (size_t)t * ((size_t)M_TOK * D_MODEL);
#pragma unroll
        for (int ai = 0; ai < 2; ++ai)
#pragma unroll
            for (int m = 0; m < 4; ++m) { bf16_t* rowp = base + (size_t)(row0 + ai * HALF + m * 16) * D_MODEL + col0;
#pragma unroll
                for (int bj = 0; bj < 2; ++bj) { if (MODE == 1) *(u32x4*)(rowp + bj * HALF) = pack8(acc[ai][bj][m][0], acc[ai][bj][m][1]);
                    else asm volatile("" :: "v"(acc[ai][bj][m][0]), "v"(acc[ai][bj][m][1])); } }
    }
};
struct EpiNull {
    static constexpr bool PERM = true, HAS_MID = false;
    __device__ __forceinline__ void mid(f32x4 (&)[2][2][4][2], const Unit&, int, int, int, int) const {}
    __device__ __forceinline__ void operator()(const f32x4 (&acc)[2][2][4][2], const Unit&, int, int, int, int) const {
#pragma unroll
        for (int ai = 0; ai < 2; ++ai)
#pragma unroll
            for (int m = 0; m < 4; ++m)
#pragma unroll
                for (int bj = 0; bj < 2; ++bj) asm volatile("" :: "v"(acc[ai][bj][m][0]), "v"(acc[ai][bj][m][1]));
    }
};
struct EpiPlain {
    static constexpr bool PERM = true, HAS_MID = false;
    bf16_t* O; int ldc;
    __device__ __forceinline__ void mid(f32x4 (&)[2][2][4][2], const Unit&, int, int, int, int) const {}
    __device__ __forceinline__ void operator()(const f32x4 (&acc)[2][2][4][2], const Unit& u, int wr, int wc, int fr, int fq) const {
        const int row0 = u.pm * BM + wr * 64 + fr, col0 = u.pn * BM + wc * 32 + 8 * fq;
#pragma unroll
        for (int ai = 0; ai < 2; ++ai)
#pragma unroll
            for (int m = 0; m < 4; ++m) { bf16_t* rowp = O + (size_t)(row0 + ai * HALF + m * 16) * ldc + col0;
#pragma unroll
                for (int bj = 0; bj < 2; ++bj) *(u32x4*)(rowp + bj * HALF) = pack8(acc[ai][bj][m][0], acc[ai][bj][m][1]); }
    }
};
struct EpiMerge {
    static constexpr bool PERM = true, HAS_MID = true;
    const bf16_t* RA; const unsigned char* SB; bf16_t* O;
    __device__ __forceinline__ void mid(f32x4 (&acc)[2][2][4][2], const Unit& u, int wr, int wc, int fr, int fq) const {
        const int row0 = u.pm * BM + wr * 64 + fr, col0 = u.pn * BM + wc * 32 + 8 * fq;
        u32x4 w[2][4][2];
#pragma unroll
        for (int ai = 0; ai < 2; ++ai)
#pragma unroll
            for (int m = 0; m < 4; ++m)
#pragma unroll
                for (int bj = 0; bj < 2; ++bj) w[ai][m][bj] = *(const u32x4*)(RA + (size_t)(row0 + ai * HALF + m * 16) * D_MODEL + col0 + bj * HALF);
#pragma unroll
        for (int ai = 0; ai < 2; ++ai)
#pragma unroll
            for (int m = 0; m < 4; ++m)
#pragma unroll
                for (int bj = 0; bj < 2; ++bj) { f32x4 a0, a1; unpack8(w[ai][m][bj], a0, a1); acc[ai][bj][m][0] *= a0; acc[ai][bj][m][1] *= a1; }
        asm volatile("" ::: "memory");
    }
    __device__ __forceinline__ void operator()(const f32x4 (&acc)[2][2][4][2], const Unit& u, int wr, int wc, int fr, int fq) const {
        const int row0 = u.pm * BM + wr * 64 + fr, col0 = u.pn * BM + wc * 32 + 8 * fq;
        u32x2 w[2][4][2];
#pragma unroll
        for (int ai = 0; ai < 2; ++ai)
#pragma unroll
            for (int m = 0; m < 4; ++m)
#pragma unroll
                for (int bj = 0; bj < 2; ++bj) w[ai][m][bj] = *(const u32x2*)(SB + (size_t)(row0 + ai * HALF + m * 16) * D_MODEL + col0 + bj * HALF);
#pragma unroll
        for (int ai = 0; ai < 2; ++ai) {
#pragma unroll
            for (int m = 0; m < 4; ++m)
#pragma unroll
                for (int bj = 0; bj < 2; ++bj) { const f32x4 b0 = unpk_gate4(w[ai][m][bj].x), b1 = unpk_gate4(w[ai][m][bj].y);
                    *(u32x4*)(O + (size_t)(row0 + ai * HALF + m * 16) * D_MODEL + col0 + bj * HALF) = pack8(acc[ai][bj][m][0] * b0, acc[ai][bj][m][1] * b1); }
            asm volatile("" ::: "memory"); }
    }
};
struct EpiResF32 {
    static constexpr bool PERM = true, HAS_MID = false;
    const float* res; bf16_t* XB; float* stat;
    __device__ __forceinline__ void mid(f32x4 (&)[2][2][4][2], const Unit&, int, int, int, int) const {}
    __device__ __forceinline__ void operator()(const f32x4 (&acc)[2][2][4][2], const Unit& u, int wr, int wc, int fr, int fq) const {
        const int row0 = u.pm * BM + wr * 64 + fr, col0 = u.pn * BM + wc * 32 + 8 * fq;
#pragma unroll
        for (int ai = 0; ai < 2; ++ai) { f32x4 r[4][2][2];
#pragma unroll
            for (int m = 0; m < 4; ++m)
#pragma unroll
                for (int bj = 0; bj < 2; ++bj) { const float* p = res + (size_t)(row0 + ai * HALF + m * 16) * D_MODEL + col0 + bj * HALF; r[m][bj][0] = *(const f32x4*)p; r[m][bj][1] = *(const f32x4*)(p + 4); }
#pragma unroll
            for (int m = 0; m < 4; ++m) { const int row = row0 + ai * HALF + m * 16; const size_t off = (size_t)row * D_MODEL + col0; float ss = 0.f;
#pragma unroll
                for (int bj = 0; bj < 2; ++bj) { const f32x4 v0 = r[m][bj][0] + acc[ai][bj][m][0], v1 = r[m][bj][1] + acc[ai][bj][m][1];
                    ss += hsq4(v0) + hsq4(v1); *(u32x4*)(XB + off + bj * HALF) = pack8(v0, v1); }
                ss += __shfl_xor(ss, 16); ss += __shfl_xor(ss, 32);
                if (fq == 0) stat[(size_t)row * 64 + u.pn * 4 + wc] = ss; }
            asm volatile("" ::: "memory"); }
    }
};
struct EpiResBf {
    static constexpr bool PERM = true, HAS_MID = false;
    bf16_t* XB; float* stat; bf16_t* XO; unsigned char* X8;
    __device__ __forceinline__ void mid(f32x4 (&)[2][2][4][2], const Unit&, int, int, int, int) const {}
    __device__ __forceinline__ void operator()(const f32x4 (&acc)[2][2][4][2], const Unit& u, int wr, int wc, int fr, int fq) const {
        const int row0 = u.pm * BM + wr * 64 + fr, col0 = u.pn * BM + wc * 32 + 8 * fq;
        u32x4 w[2][4][2];
#pragma unroll
        for (int ai = 0; ai < 2; ++ai)
#pragma unroll
            for (int m = 0; m < 4; ++m)
#pragma unroll
                for (int bj = 0; bj < 2; ++bj) w[ai][m][bj] = *(const u32x4*)(XB + (size_t)(row0 + ai * HALF + m * 16) * D_MODEL + col0 + bj * HALF);
#pragma unroll
        for (int ai = 0; ai < 2; ++ai) {
#pragma unroll
            for (int m = 0; m < 4; ++m) { const int row = row0 + ai * HALF + m * 16; const size_t off = (size_t)row * D_MODEL + col0; float ss = 0.f;
#pragma unroll
                for (int bj = 0; bj < 2; ++bj) { f32x4 r0, r1; unpack8(w[ai][m][bj], r0, r1); const f32x4 v0 = r0 + acc[ai][bj][m][0], v1 = r1 + acc[ai][bj][m][1];
                    ss += hsq4(v0) + hsq4(v1); *(u32x4*)(XO + off + bj * HALF) = pack8(v0, v1);
                    const f32x4 s0 = v0 * F8_SA, s1 = v1 * F8_SA; *(u32x2*)(X8 + off + bj * HALF) = (u32x2){pk_fp8x4(s0[0], s0[1], s0[2], s0[3]), pk_fp8x4(s1[0], s1[1], s1[2], s1[3])}; }
                ss += __shfl_xor(ss, 16); ss += __shfl_xor(ss, 32);
                if (fq == 0) stat[(size_t)row * 64 + u.pn * 4 + wc] = ss; }
            asm volatile("" ::: "memory"); }
    }
};
struct RowScale { const LAS float* rs_lds; int rs_pm; const float* stat;
    __device__ __forceinline__ float get(const Unit& u, int rt, int row, int fq) const { return (u.pm == rs_pm) ? rs_lds[rt] : row_rstd(stat, row, fq, RMS_EPS); } };
struct EpiSwiglu {
    static constexpr bool PERM = true, HAS_MID = false;
    RowScale rsc; bf16_t* O;
    __device__ __forceinline__ void mid(f32x4 (&)[2][2][4][2], const Unit&, int, int, int, int) const {}
    __device__ __forceinline__ void operator()(const f32x4 (&acc)[2][2][4][2], const Unit& u, int wr, int wc, int fr, int fq) const {
        const int rt0 = wr * 64 + fr, row0 = u.pm * BM + rt0, col0 = u.pn * HALF + wc * 32 + 8 * fq;
#pragma unroll
        for (int ai = 0; ai < 2; ++ai)
#pragma unroll
            for (int m = 0; m < 4; ++m) { const int row = row0 + ai * HALF + m * 16; const float rs = rsc.get(u, rt0 + ai * HALF + m * 16, row, fq);
                f32x4 h0, h1;
#pragma unroll
                for (int j = 0; j < 4; ++j) { const float g0 = acc[ai][0][m][0][j] * rs, g1 = acc[ai][0][m][1][j] * rs;
                    h0[j] = g0 * sigm(g0) * (acc[ai][1][m][0][j] * rs); h1[j] = g1 * sigm(g1) * (acc[ai][1][m][1][j] * rs); }
                *(u32x4*)(O + (size_t)row * D_FF + col0) = pack8(h0, h1); }
    }
};
struct EpiPle {
    static constexpr bool PERM = true, HAS_MID = false;
    RowScale rsc; const bf16_t* XB2; const bf16_t* PP; bf16_t* X3; float* stat3;
    __device__ __forceinline__ void mid(f32x4 (&)[2][2][4][2], const Unit&, int, int, int, int) const {}
    __device__ __forceinline__ void operator()(const f32x4 (&acc)[2][2][4][2], const Unit& u, int wr, int wc, int fr, int fq) const {
        const int rt0 = wr * 64 + fr, row0 = u.pm * BM + rt0, col0 = u.pn * BM + wc * 32 + 8 * fq;
#pragma unroll
        for (int ai = 0; ai < 2; ++ai) { u32x4 wx[4][2], wp[4][2];
#pragma unroll
            for (int m = 0; m < 4; ++m)
#pragma unroll
                for (int bj = 0; bj < 2; ++bj) { const size_t off = (size_t)(row0 + ai * HALF + m * 16) * D_MODEL + col0 + bj * HALF; wx[m][bj] = *(const u32x4*)(XB2 + off); wp[m][bj] = *(const u32x4*)(PP + off); }
#pragma unroll
            for (int m = 0; m < 4; ++m) { const int row = row0 + ai * HALF + m * 16; const size_t off = (size_t)row * D_MODEL + col0; float ss = 0.f;
                const float rs = rsc.get(u, rt0 + ai * HALF + m * 16, row, fq) * F8_DESC;
#pragma unroll
                for (int bj = 0; bj < 2; ++bj) { f32x4 r0, r1, p0, p1; unpack8(wx[m][bj], r0, r1); unpack8(wp[m][bj], p0, p1);
                    const f32x4 v0 = r0 + sigm4(acc[ai][bj][m][0] * rs) * p0, v1 = r1 + sigm4(acc[ai][bj][m][1] * rs) * p1;
                    ss += hsq4(v0) + hsq4(v1); *(u32x4*)(X3 + off + bj * HALF) = pack8(v0, v1); }
                ss += __shfl_xor(ss, 16); ss += __shfl_xor(ss, 32);
                if (fq == 0) stat3[(size_t)row * 64 + u.pn * 4 + wc] = ss; }
            asm volatile("" ::: "memory"); }
    }
};

__device__ __forceinline__ i32x8 cat8(bf16x8 a, bf16x8 b) { const i32x4 x = __builtin_bit_cast(i32x4, a), y = __builtin_bit_cast(i32x4, b); return __builtin_shufflevector(x, y, 0, 1, 2, 3, 4, 5, 6, 7); }
__device__ __forceinline__ void mfma_f8(f32x4& acc, i32x8 a, i32x8 b) { asm volatile("v_mfma_f32_16x16x128_f8f6f4 %0, %1, %2, %0" : "+v"(acc) : "v"(a), "v"(b)); }
template <class Epi, class Sched, bool ALIGN_EPI, bool SP2, bool F8 = false>
__device__ __forceinline__ void gemm_phase(LAS unsigned char* lds, const Gemm g, const Sched& S, const Epi& E, const int wid) {
    int lane = lane_id(); asm volatile("" : "+v"(lane));
    const int tid = wid * 64 + lane, wr = wid >> 2, wc = wid & 3, fr = lane & 15, fq = lane >> 4;
    int nt = g.K / BK, nt1 = g.nt1; asm volatile("" : "+s"(nt), "+s"(nt1));
    const int ld = g.ld;
    unsigned voffA[2], voffB[2];
#pragma unroll
    for (int i = 0; i < 2; ++i) { int R, C; stage_rc(tid * 16 + i * 8192, R, C); const int Rb = Epi::PERM ? ((R & ~31) + perm32(R & 31)) : R;
        voffA[i] = (unsigned)(R * ld + C) * 2u; voffB[i] = (unsigned)(Rb * ld + C) * 2u; }
    const size_t kstep = (size_t)(BK * 2);
    const size_t hstep = (size_t)HALF * ld * 2;
    const size_t tstep = 2 * hstep;
    const size_t seg2 = (size_t)nt1 * kstep;
    const unsigned ldsw = (unsigned)wid * 1024u;
    const int aoff = lds_byte(wr * 64 + fr, fq * 8), boff = lds_byte(wc * 32 + fr, fq * 8);
#define PG8_SA(b, h) (((b) * 2 + (h)) * HTB)
#define PG8_SB(b, h) ((4 + (b) * 2 + (h)) * HTB)
#define PG8_STAGE(bufoff, gbase, voff) do { _Pragma("unroll") for (int _i = 0; _i < 2; ++_i) \
        __builtin_amdgcn_global_load_lds((const unsigned*)((const char*)(gbase) + (voff)[_i]), (LAS unsigned*)(lds + (bufoff) + ldsw + _i * 8192), 16, 0, 0); } while (0)
#define PG8_LDA(dst, b, h) do { _Pragma("unroll") for (int m = 0; m < 4; ++m) _Pragma("unroll") for (int k = 0; k < 2; ++k) dst[m][k] = *(const LAS bf16x8*)(lds + PG8_SA(b, h) + aoff + m * 2048 + k * 1024); } while (0)
#define PG8_LDB(dst, b, h) do { _Pragma("unroll") for (int n = 0; n < 2; ++n) _Pragma("unroll") for (int k = 0; k < 2; ++k) dst[n][k] = *(const LAS bf16x8*)(lds + PG8_SB(b, h) + boff + n * 2048 + k * 1024); } while (0)
#define PG8_MMA(ai, bj, At, Bt) do { __builtin_amdgcn_s_setprio(1); \
        if constexpr (F8) { _Pragma("unroll") for (int m = 0; m < 4; ++m) _Pragma("unroll") for (int n = 0; n < 2; ++n) \
            mfma_f8(acc[ai][bj][m][n], cat8(Bt[n][0], Bt[n][1]), cat8(At[m][0], At[m][1])); } \
        else { _Pragma("unroll") for (int m = 0; m < 4; ++m) _Pragma("unroll") for (int n = 0; n < 2; ++n) _Pragma("unroll") for (int k = 0; k < 2; ++k) \
            acc[ai][bj][m][n] = __builtin_amdgcn_mfma_f32_16x16x32_bf16(Bt[n][k], At[m][k], acc[ai][bj][m][n], 0, 0, 0); } \
        __builtin_amdgcn_s_setprio(0); } while (0)
#define PG8_WAIT_V(n) asm volatile("s_waitcnt vmcnt(" #n ")" ::: "memory")
#define PG8_WAIT_L(n) asm volatile("s_waitcnt lgkmcnt(" #n ")" ::: "memory")
#define PG8_BAR __builtin_amdgcn_s_barrier()
#define PG8_SCHED __builtin_amdgcn_sched_barrier(0)
    Unit cur, nxt; int ui = 0;
    if (!S.next(0, cur)) return;
    f32x4 acc[2][2][4][2];
#pragma unroll
    for (int a = 0; a < 2; ++a)
#pragma unroll
        for (int b = 0; b < 2; ++b)
#pragma unroll
            for (int m = 0; m < 4; ++m)
#pragma unroll
                for (int n = 0; n < 2; ++n) acc[a][b][m][n] = (f32x4){0.f, 0.f, 0.f, 0.f};
    bf16x8 At[4][2], B0[2][2], B1[2][2];
    const char* cA = (const char*)g.A + (size_t)cur.pm * tstep; const char* cB = (const char*)g.Bt + (size_t)cur.pn * tstep;
    const char* cA2 = (const char*)g.A2 + (size_t)cur.pm * tstep - seg2; const char* cB2 = (const char*)g.Bt2 + (size_t)cur.pn * tstep - seg2;
    if constexpr (SP2) {
        PG8_STAGE(PG8_SB(0, 0), cB, voffB); PG8_STAGE(PG8_SB(0, 1), cB + hstep, voffB); PG8_STAGE(PG8_SA(0, 0), cA, voffA); PG8_STAGE(PG8_SA(0, 1), cA + hstep, voffA);
        if (wr == 1) PG8_BAR;
        PG8_WAIT_V(2); PG8_BAR;
        PG8_STAGE(PG8_SB(1, 0), cB + kstep, voffB); PG8_STAGE(PG8_SA(1, 0), cA + kstep, voffA); PG8_STAGE(PG8_SB(1, 1), cB + hstep + kstep, voffB);
        PG8_WAIT_V(6); PG8_BAR;
    } else {
        PG8_STAGE(PG8_SB(0, 0), cB, voffB); PG8_STAGE(PG8_SA(0, 0), cA, voffA); PG8_STAGE(PG8_SB(0, 1), cB + hstep, voffB); PG8_STAGE(PG8_SA(0, 1), cA + hstep, voffA);
        if (wr == 1) PG8_BAR;
        PG8_WAIT_V(4); PG8_BAR;
        PG8_STAGE(PG8_SB(1, 0), cB + kstep, voffB); PG8_STAGE(PG8_SA(1, 0), cA + kstep, voffA); PG8_STAGE(PG8_SB(1, 1), cB + hstep + kstep, voffB);
        PG8_WAIT_V(6); PG8_BAR;
    }
    for (;;) {
        const bool has_next = S.next(ui + 1, nxt);
        const char* nA = has_next ? (const char*)g.A + (size_t)nxt.pm * tstep : cA; const char* nB = has_next ? (const char*)g.Bt + (size_t)nxt.pn * tstep : cB;
        for (int t = 0; t < nt; t += 2) {
            const bool last = (t == nt - 2);
            const char* a1 = ((t + 1 < nt1) ? cA : cA2) + (size_t)(t + 1) * kstep;
            const bool s1 = (t + 2 < nt1);
            const char* a2 = last ? nA : (s1 ? cA : cA2) + (size_t)(t + 2) * kstep; const char* b2 = last ? nB : (s1 ? cB : cB2) + (size_t)(t + 2) * kstep;
            const char* a3 = a2 + kstep; const char* b3 = b2 + kstep;
            if constexpr (Epi::HAS_MID) { if (t == nt1) { int l2 = lane; asm volatile("" : "+v"(l2)); E.mid(acc, cur, wr, wc, l2 & 15, l2 >> 4); } }
            if constexpr (SP2) {
            PG8_LDB(B0, 0, 0); PG8_LDB(B1, 0, 1); PG8_SCHED; PG8_LDA(At, 0, 0); PG8_STAGE(PG8_SA(1, 1), a1 + hstep, voffA);
            PG8_WAIT_V(8); PG8_WAIT_L(0); PG8_BAR; PG8_MMA(0, 0, At, B0); PG8_MMA(0, 1, At, B1); PG8_BAR; PG8_SCHED;
            PG8_LDA(At, 0, 1); PG8_STAGE(PG8_SB(0, 0), b2, voffB); PG8_STAGE(PG8_SB(0, 1), b2 + hstep, voffB); PG8_STAGE(PG8_SA(0, 0), a2, voffA);
            PG8_WAIT_V(8); PG8_WAIT_L(0); PG8_BAR; PG8_MMA(1, 0, At, B0); PG8_MMA(1, 1, At, B1); PG8_BAR; PG8_SCHED;
            PG8_LDB(B0, 1, 0); PG8_LDB(B1, 1, 1); PG8_SCHED; PG8_LDA(At, 1, 0); PG8_STAGE(PG8_SA(0, 1), a2 + hstep, voffA);
            PG8_WAIT_V(8); PG8_WAIT_L(0); PG8_BAR; PG8_MMA(0, 0, At, B0); PG8_MMA(0, 1, At, B1); PG8_BAR; PG8_SCHED;
            PG8_LDA(At, 1, 1); PG8_STAGE(PG8_SB(1, 0), b3, voffB); PG8_STAGE(PG8_SB(1, 1), b3 + hstep, voffB); PG8_STAGE(PG8_SA(1, 0), a3, voffA);
            PG8_WAIT_V(8); PG8_WAIT_L(0); PG8_BAR; PG8_MMA(1, 0, At, B0); PG8_MMA(1, 1, At, B1); PG8_BAR; PG8_SCHED;
            } else {
            PG8_LDB(B0, 0, 0); PG8_SCHED; PG8_LDA(At, 0, 0); PG8_STAGE(PG8_SA(1, 1), a1 + hstep, voffA);
            PG8_WAIT_L(8); PG8_BAR; PG8_WAIT_L(0); PG8_MMA(0, 0, At, B0); PG8_BAR; PG8_SCHED;
            PG8_LDB(B1, 0, 1); PG8_STAGE(PG8_SB(0, 0), b2, voffB);
            PG8_BAR; PG8_WAIT_L(0); PG8_MMA(0, 1, At, B1); PG8_BAR;
            PG8_LDA(At, 0, 1); PG8_STAGE(PG8_SA(0, 0), a2, voffA);
            PG8_BAR; PG8_WAIT_L(0); PG8_MMA(1, 0, At, B0); PG8_BAR; PG8_SCHED;
            PG8_STAGE(PG8_SB(0, 1), b2 + hstep, voffB);
            PG8_WAIT_V(6); PG8_BAR; PG8_MMA(1, 1, At, B1); PG8_BAR;
            PG8_LDB(B0, 1, 0); PG8_SCHED; PG8_LDA(At, 1, 0); PG8_STAGE(PG8_SA(0, 1), a2 + hstep, voffA);
            PG8_WAIT_L(8); PG8_BAR; PG8_WAIT_L(0); PG8_MMA(0, 0, At, B0); PG8_BAR; PG8_SCHED;
            PG8_LDB(B1, 1, 1); PG8_STAGE(PG8_SB(1, 0), b3, voffB);
            PG8_BAR; PG8_WAIT_L(0); PG8_MMA(0, 1, At, B1); PG8_BAR;
            PG8_LDA(At, 1, 1); PG8_STAGE(PG8_SA(1, 0), a3, voffA);
            PG8_BAR; PG8_WAIT_L(0); PG8_MMA(1, 0, At, B0); PG8_BAR; PG8_SCHED;
            PG8_STAGE(PG8_SB(1, 1), b3 + hstep, voffB);
            PG8_WAIT_V(6); PG8_BAR; PG8_MMA(1, 1, At, B1); PG8_BAR;
            }
        }
        if constexpr (ALIGN_EPI) { if (wr == 0) PG8_BAR; }
        if constexpr (F8) asm volatile("s_nop 15\n\ts_nop 15" ::: "memory");
        { int l2 = lane; asm volatile("" : "+v"(l2)); E(acc, cur, wr, wc, l2 & 15, l2 >> 4); }
        if (!has_next) break;
#pragma unroll
        for (int a = 0; a < 2; ++a)
#pragma unroll
            for (int b = 0; b < 2; ++b)
#pragma unroll
                for (int m = 0; m < 4; ++m)
#pragma unroll
                    for (int n = 0; n < 2; ++n) acc[a][b][m][n] = (f32x4){0.f, 0.f, 0.f, 0.f};
        cur = nxt; cA = nA; cB = nB; ++ui;
        cA2 = (const char*)g.A2 + (size_t)cur.pm * tstep - seg2; cB2 = (const char*)g.Bt2 + (size_t)cur.pn * tstep - seg2;
        if constexpr (ALIGN_EPI) { if (wr == 1) PG8_BAR; }
    }
    PG8_WAIT_V(0);
    if constexpr (!ALIGN_EPI) { if (wr == 0) PG8_BAR; }
    PG8_BAR;
#undef PG8_SA
#undef PG8_SB
#undef PG8_STAGE
#undef PG8_LDA
#undef PG8_LDB
#undef PG8_MMA
#undef PG8_WAIT_V
#undef PG8_WAIT_L
#undef PG8_BAR
#undef PG8_SCHED
}
}

namespace att {
constexpr int STG = 65536;
__device__ __forceinline__ const char* uni_ptr(const char* p) { const unsigned long long v = (unsigned long long)p; const unsigned lo = __builtin_amdgcn_readfirstlane((unsigned)v), hi = __builtin_amdgcn_readfirstlane((unsigned)(v >> 32)); return (const char*)(((unsigned long long)hi << 32) | lo); }
#define KSWZ(row, colB) ((row) * 256 + ((colB) ^ (((row) & 7) << 4)))
__device__ __forceinline__ int crow(int r, int hi) { return (r & 3) + 8 * (r >> 2) + 4 * hi; }
__device__ __forceinline__ int v_rd_base(int lane) { return ((lane & 3) << 3) | (((lane >> 2) & 3) << 6) | (((lane >> 4) & 1) << 5) | (((lane >> 5) & 1) << 8); }
constexpr int v_rd_off(int d0, int ks, int half) { return d0 * 512 + ks * 4096 + half * 2048; }
template <int OFF> __device__ __forceinline__ s16x4 tr_read(int vb) { s16x4 r; asm volatile("ds_read_b64_tr_b16 %0, %1 offset:%2" : "=&v"(r) : "v"(vb), "i"(OFF) : "memory"); return r; }
template <int D0> __device__ __forceinline__ void pv_one(f32x16& od, int vb, bf16x8 pa0, bf16x8 pa1, bf16x8 pa2, bf16x8 pa3) {
    const s16x4 l0 = tr_read<v_rd_off(D0, 0, 0)>(vb), h0 = tr_read<v_rd_off(D0, 0, 1)>(vb), l1 = tr_read<v_rd_off(D0, 1, 0)>(vb), h1 = tr_read<v_rd_off(D0, 1, 1)>(vb);
    const s16x4 l2 = tr_read<v_rd_off(D0, 2, 0)>(vb), h2 = tr_read<v_rd_off(D0, 2, 1)>(vb), l3 = tr_read<v_rd_off(D0, 3, 0)>(vb), h3 = tr_read<v_rd_off(D0, 3, 1)>(vb);
    asm volatile("s_waitcnt lgkmcnt(0)" ::: "memory"); __builtin_amdgcn_sched_barrier(0);
#define PK(L, H) (bf16x8){L[0], L[1], L[2], L[3], H[0], H[1], H[2], H[3]}
    od = __builtin_amdgcn_mfma_f32_32x32x16_bf16(pa0, PK(l0, h0), od, 0, 0, 0);
    od = __builtin_amdgcn_mfma_f32_32x32x16_bf16(pa1, PK(l1, h1), od, 0, 0, 0);
    od = __builtin_amdgcn_mfma_f32_32x32x16_bf16(pa2, PK(l2, h2), od, 0, 0, 0);
    od = __builtin_amdgcn_mfma_f32_32x32x16_bf16(pa3, PK(l3, h3), od, 0, 0, 0);
#undef PK
}
template <int D0> __device__ __forceinline__ void pv_ld(s16x4 (&t)[8], int vb) {
    constexpr int B = (D0 >> 2) * 16384, D = D0 & 3;
    t[0] = tr_read<B + v_rd_off(D, 0, 0)>(vb); t[1] = tr_read<B + v_rd_off(D, 0, 1)>(vb); t[2] = tr_read<B + v_rd_off(D, 1, 0)>(vb); t[3] = tr_read<B + v_rd_off(D, 1, 1)>(vb);
    t[4] = tr_read<B + v_rd_off(D, 2, 0)>(vb); t[5] = tr_read<B + v_rd_off(D, 2, 1)>(vb); t[6] = tr_read<B + v_rd_off(D, 3, 0)>(vb); t[7] = tr_read<B + v_rd_off(D, 3, 1)>(vb);
}
__device__ __forceinline__ void pv_mm(f32x16& od, const s16x4 (&t)[8], bf16x8 pa0, bf16x8 pa1, bf16x8 pa2, bf16x8 pa3) {
#define PK(L, H) (bf16x8){L[0], L[1], L[2], L[3], H[0], H[1], H[2], H[3]}
    od = __builtin_amdgcn_mfma_f32_32x32x16_bf16(pa0, PK(t[0], t[1]), od, 0, 0, 0);
    od = __builtin_amdgcn_mfma_f32_32x32x16_bf16(pa1, PK(t[2], t[3]), od, 0, 0, 0);
    od = __builtin_amdgcn_mfma_f32_32x32x16_bf16(pa2, PK(t[4], t[5]), od, 0, 0, 0);
    od = __builtin_amdgcn_mfma_f32_32x32x16_bf16(pa3, PK(t[6], t[7]), od, 0, 0, 0);
#undef PK
}
#define PV_WAIT(n) do { asm volatile("s_waitcnt lgkmcnt(" #n ")" ::: "memory"); __builtin_amdgcn_sched_barrier(0); } while (0)
__device__ __forceinline__ void pv_all(f32x16 (&o)[8], int vb, bf16x8 pa0, bf16x8 pa1, bf16x8 pa2, bf16x8 pa3) {
    s16x4 ta[8], tb[8];
    pv_ld<0>(ta, vb);
    pv_ld<1>(tb, vb); PV_WAIT(8); pv_mm(o[0], ta, pa0, pa1, pa2, pa3);
    pv_ld<2>(ta, vb); PV_WAIT(8); pv_mm(o[1], tb, pa0, pa1, pa2, pa3);
    pv_ld<3>(tb, vb); PV_WAIT(8); pv_mm(o[2], ta, pa0, pa1, pa2, pa3);
    pv_ld<4>(ta, vb); PV_WAIT(8); pv_mm(o[3], tb, pa0, pa1, pa2, pa3);
    pv_ld<5>(tb, vb); PV_WAIT(8); pv_mm(o[4], ta, pa0, pa1, pa2, pa3);
    pv_ld<6>(ta, vb); PV_WAIT(8); pv_mm(o[5], tb, pa0, pa1, pa2, pa3);
    pv_ld<7>(tb, vb); PV_WAIT(8); pv_mm(o[6], ta, pa0, pa1, pa2, pa3);
    PV_WAIT(0); pv_mm(o[7], tb, pa0, pa1, pa2, pa3);
}
#define ATT_BAR() do { asm volatile("s_waitcnt vmcnt(0) lgkmcnt(0)" ::: "memory"); __builtin_amdgcn_s_barrier(); asm volatile("" ::: "memory"); } while (0)

template <int VAR  >
__device__ __forceinline__ void attn_unit(LAS unsigned char* lds, LAS float* scr, const bf16_t* Qg, const bf16_t* Kg, const bf16_t* Vg, bf16_t* Og,
                                          int b, int h, int qb, float lam, float slope2, const float* subln_g, const unsigned* kn, int wid, int lane) {
    asm volatile("" : "+v"(lane));
    const int mp = wid >> 2, rq = wid & 3, r32 = lane & 31, hi = lane >> 5;
    const int q0 = qb * 128, NT = 2 * qb + 2;
    const size_t rowbase = (size_t)b * SEQ;
    unsigned koff[2], voff[2];
#pragma unroll
    for (int j = 0; j < 2; ++j) {
        const int blk = j * 8 + wid;
        { const int row = blk * 4 + (lane >> 4), chunk = (lane & 15) ^ (row & 7); koff[j] = (unsigned)(row * D_MODEL + chunk * 8) * 2u; }
        { const int sub = blk * 2 + (lane >> 5), kk = (sub >> 2) * 8 + ((lane & 31) >> 2), k = (kk & ~0xC) | ((kk & 4) << 1) | ((kk & 8) >> 1);
          voff[j] = (unsigned)(k * D_MODEL + (sub & 3) * 32 + (lane & 3) * 8) * 2u; }
    }
    const char* Kh = uni_ptr((const char*)(Kg + rowbase * D_MODEL + h * 256));
    const char* Vh = uni_ptr((const char*)(Vg + rowbase * D_MODEL + h * 256));
#define ATT_ISSUE(t, stg) do { const char* kt_ = Kh + (size_t)(t) * (64 * D_MODEL * 2); const char* vt_ = Vh + (size_t)(t) * (64 * D_MODEL * 2); LAS unsigned char* sb_ = lds + (stg) * STG + wid * 1024; \
        _Pragma("unroll") for (int i_ = 0; i_ < 8; ++i_) { const char* ub_ = (i_ < 4) ? kt_ + (i_ >> 1) * 256 : vt_ + ((i_ >> 1) & 1) * 256; const unsigned vo_ = (i_ < 4) ? koff[i_ & 1] : voff[i_ & 1]; \
            __builtin_amdgcn_global_load_lds((const unsigned*)(ub_ + vo_), (LAS unsigned*)(sb_ + i_ * 8192), 16, 0, 0); } } while (0)
    ATT_ISSUE(NT - 1, 0);
    bf16x8 qr[8];
    { const bf16_t* Qw = Qg + (rowbase + q0 + 32 * rq + r32) * D_MODEL + h * 256 + mp * 128 + hi * 8;
#pragma unroll
      for (int d0 = 0; d0 < 8; ++d0) qr[d0] = *(const bf16x8*)(Qw + d0 * 16); }
    int kb[16];
#pragma unroll
    for (int r = 0; r < 16; ++r) { const float kv = slope2 * (float)((r & 3) + 8 * (r >> 2)); asm volatile("s_nop 0\n\tv_readfirstlane_b32 %0, %1" : "=s"(kb[r]) : "v"(kv)); }
    const float off32 = 32.f * slope2;
    f32x16 o[8];
#pragma unroll
    for (int d = 0; d < 8; ++d) o[d] = (f32x16){0.f, 0.f, 0.f, 0.f, 0.f, 0.f, 0.f, 0.f, 0.f, 0.f, 0.f, 0.f, 0.f, 0.f, 0.f, 0.f};
    float m_run = -1e30f, l_run = 0.f;
    const int vb0 = (int)(uintptr_t)(lds) + 32768 + v_rd_base(lane);
    LAS float* al_l = scr + wid * 64;
    { float q2 = 0.f;
#pragma unroll
      for (int d0 = 0; d0 < 8; ++d0) { const u32x4 w = __builtin_bit_cast(u32x4, qr[d0]);
          q2 += bflo(w.x) * bflo(w.x) + bfhi(w.x) * bfhi(w.x) + bflo(w.y) * bflo(w.y) + bfhi(w.y) * bfhi(w.y) + bflo(w.z) * bflo(w.z) + bfhi(w.z) * bfhi(w.z) + bflo(w.w) * bflo(w.w) + bfhi(w.w) * bfhi(w.w); }
      { auto rr = __builtin_amdgcn_permlane32_swap(__float_as_uint(q2), __float_as_uint(q2), false, false); q2 = __uint_as_float(rr[0]) + __uint_as_float(rr[1]); }
      q2 = fmaxf(q2, swz_xor<1>(q2)); q2 = fmaxf(q2, swz_xor<2>(q2)); q2 = fmaxf(q2, swz_xor<4>(q2)); q2 = fmaxf(q2, swz_xor<8>(q2)); q2 = fmaxf(q2, swz_xor<16>(q2));
      if (lane == 0) al_l[40] = q2; }
    int jmax = NT;
    if (wid >= 4) __builtin_amdgcn_s_setprio(1);
    for (int j = 0; j < jmax; ++j) {
        const int t = NT - 1 - j, stg = j & 1;
        ATT_BAR();
        if (j == 0) {
            float q2m = 0.f;
#pragma unroll
            for (int w8 = 0; w8 < 8; ++w8) q2m = fmaxf(q2m, scr[w8 * 64 + 40]);
            const unsigned* kp = kn + ((b * 16 + h) * 2) * 4;
            const float k2 = 1.02f * fmaxf((__uint_as_float(kp[0]) + __uint_as_float(kp[1])) + (__uint_as_float(kp[2]) + __uint_as_float(kp[3])), (__uint_as_float(kp[4]) + __uint_as_float(kp[5])) + (__uint_as_float(kp[6]) + __uint_as_float(kp[7])));
            const float W = (158.f + 2.f * sqrtf(q2m * k2)) / slope2;
            const float xs = ((float)(q0 - 63) - W) * (1.f / 64.f);
            int ts = xs > 0.f ? (int)ceilf(xs) : 0; ts = ts < NT - 2 ? ts : NT - 2;
            jmax = NT - __builtin_amdgcn_readfirstlane(ts);
        }
        if (j + 1 < jmax) ATT_ISSUE(t - 1, stg ^ 1);
        const LAS unsigned char* Ks = lds + stg * STG + mp * 16384;
        f32x16 p0, p1;
#pragma unroll
        for (int r = 0; r < 16; ++r) { int sb = kb[r]; asm volatile("" : "+s"(sb)); p0[r] = __int_as_float(sb); p1[r] = __int_as_float(sb); }
#pragma unroll
        for (int d0 = 0; d0 < 8; ++d0) { const int cb = (d0 * 16 + hi * 8) * 2;
            const bf16x8 b0 = *(const LAS bf16x8*)(Ks + KSWZ(r32, cb)), b1 = *(const LAS bf16x8*)(Ks + KSWZ(32 + r32, cb));
            p0 = __builtin_amdgcn_mfma_f32_32x32x16_bf16(b0, qr[d0], p0, 0, 0, 0);
            p1 = __builtin_amdgcn_mfma_f32_32x32x16_bf16(b1, qr[d0], p1, 0, 0, 0);
            if ((d0 & 3) == 3) asm volatile("" ::: "memory"); }
        if (t >= NT - 2) {
            const int lim = q0 + 32 * rq + r32 - 64 * t - 4 * hi;
#pragma unroll
            for (int r = 0; r < 16; ++r) { const int cr = (r & 3) + 8 * (r >> 2); p0[r] = (cr > lim) ? -__builtin_inff() : p0[r]; p1[r] = (cr + 32 > lim) ? -__builtin_inff() : p1[r]; }
        }
        const float gt = slope2 * (float)(64 * (t - NT) + 4 * hi);
        float pmax = p0[0], pmax1 = p1[0];
#pragma unroll
        for (int r = 1; r < 16; ++r) { if (VAR < 2) { pmax = fmaxf(pmax, p0[r]); pmax1 = fmaxf(pmax1, p1[r]); } }
        pmax = fmaxf(pmax, pmax1 + off32) + gt;
        { auto rr = __builtin_amdgcn_permlane32_swap(__float_as_uint(pmax), __float_as_uint(pmax), false, false); pmax = fmaxf(__uint_as_float(rr[0]), __uint_as_float(rr[1])); }
        float alpha = 1.f;
        if (!__all(pmax - m_run <= 8.f)) { const float mn = fmaxf(m_run, pmax); alpha = __builtin_amdgcn_exp2f(m_run - mn); m_run = mn; }
        const float mm = m_run - gt, mm1 = mm - off32;
        float ps = 0.f;
#pragma unroll
        for (int r = 0; r < 16; ++r) { if (VAR == 0) { p0[r] = __builtin_amdgcn_exp2f(p0[r] - mm); p1[r] = __builtin_amdgcn_exp2f(p1[r] - mm1); ps += p0[r] + p1[r]; }
            else if (VAR == 1) { p0[r] = (p0[r] - mm) * 1e-3f; p1[r] = (p1[r] - mm1) * 1e-3f; ps += p0[r] + p1[r]; } }
        { auto rr = __builtin_amdgcn_permlane32_swap(__float_as_uint(ps), __float_as_uint(ps), false, false); ps = __uint_as_float(rr[0]) + __uint_as_float(rr[1]); }
        l_run = l_run * alpha + ps;
        bf16x8 pa0, pa1, pa2, pa3;
#define PK4(P, BASE, OUT) do { const unsigned a0 = cvt_pk_bf16(P[BASE + 0], P[BASE + 1]), a1 = cvt_pk_bf16(P[BASE + 2], P[BASE + 3]);   \
    const unsigned b0 = cvt_pk_bf16(P[BASE + 4], P[BASE + 5]), b1 = cvt_pk_bf16(P[BASE + 6], P[BASE + 7]);                              \
    auto r0 = __builtin_amdgcn_permlane32_swap(a0, b0, false, false); auto r1 = __builtin_amdgcn_permlane32_swap(a1, b1, false, false); \
    u32x4 w = {r0[0], r1[0], r0[1], r1[1]}; OUT = *reinterpret_cast<bf16x8*>(&w); } while (0)
        PK4(p0, 0, pa0); PK4(p0, 8, pa1); PK4(p1, 0, pa2); PK4(p1, 8, pa3);
#undef PK4
        if (__any(alpha < 1.f)) {
            if (hi == 0) al_l[r32] = alpha;
            asm volatile("s_waitcnt lgkmcnt(0)" ::: "memory");
#pragma unroll
            for (int r = 0; r < 16; ++r) { const float a = al_l[crow(r, hi)];
#pragma unroll
                for (int d = 0; d < 8; ++d) o[d][r] *= a; }
        }
        const int vb = vb0 + stg * STG;
        pv_all(o, vb, pa0, pa1, pa2, pa3);
    }
    __builtin_amdgcn_s_setprio(0);
    ATT_BAR();
    { int l2 = lane; asm volatile("" : "+v"(l2)); lane = l2; }
    const int r32e = lane & 31, hie = lane >> 5;
    if (hie == 0) al_l[r32e] = l_run;
    asm volatile("s_waitcnt lgkmcnt(0)" ::: "memory");
#pragma unroll
    for (int r = 0; r < 16; ++r) { float a = __builtin_amdgcn_rcpf(al_l[(r & 3) + 8 * (r >> 2) + 4 * hie]); if (mp == 1) a *= lam;
#pragma unroll
        for (int d = 0; d < 8; ++d) o[d][r] *= a; }
    LAS float* X = (LAS float*)(lds + rq * 32768) + lane;
    if (mp == 1) {
#pragma unroll
        for (int d = 0; d < 8; ++d) {
#pragma unroll
            for (int r = 0; r < 16; ++r) X[(d * 16 + r) * 64] = o[d][r];
            asm volatile("" ::: "memory"); }
    }
    ATT_BAR();
    if (mp == 0) {
        float ss[16];
#pragma unroll
        for (int r = 0; r < 16; ++r) ss[r] = 0.f;
#pragma unroll
        for (int d = 0; d < 8; ++d) {
#pragma unroll
            for (int r = 0; r < 16; ++r) { const float v = o[d][r] - X[(d * 16 + r) * 64]; X[(d * 16 + r) * 64] = v; ss[r] += v * v; if (r == 7) asm volatile("" ::: "memory"); }
            asm volatile("" ::: "memory"); }
#pragma unroll
        for (int r = 0; r < 16; ++r) { const float f = rsqrtf(half_sum(ss[r]) * (1.0f / V_HEAD_DIM) + LN_EPS) * (1.0f - LAM_INIT); if (r32e == 0) al_l[(r & 3) + 8 * (r >> 2) + 4 * hie] = f; }
        asm volatile("s_waitcnt lgkmcnt(0)" ::: "memory");
        const f32x4 g0 = *(const f32x4*)(subln_g + 8 * r32e), g1 = *(const f32x4*)(subln_g + 8 * r32e + 4);
        const LAS float* Xr = (const LAS float*)(lds + rq * 32768) + (r32e >> 2) * 1024 + (r32e & 3) * 8;
        bf16_t* Ow = Og + (rowbase + q0 + 32 * rq + hie) * D_MODEL + h * 256 + 8 * r32e;
#pragma unroll
        for (int j = 0; j < 16; ++j) { int q = 2 * j; asm volatile("" : "+v"(q)); q += hie;
            const int rr = (q & 3) + 4 * (q >> 3), hh = (q >> 2) & 1;
            const LAS float* xp = Xr + rr * 64 + hh * 32; const f32x4 v0 = *(const LAS f32x4*)xp, v1 = *(const LAS f32x4*)(xp + 4); const float f = al_l[q];
            *(u32x4*)(Ow + (size_t)(2 * j) * D_MODEL) = pg8::pack8(v0 * f * g0, v1 * f * g1); }
    }
    ATT_BAR();
#undef ATT_ISSUE
}
}

constexpr size_t MiB = 1u << 20;
constexpr size_t WS_CTL = 0, CTL_ZERO_BYTES = 65536;
constexpr size_t WS_STATV = 2 * MiB, WS_STAT1 = 10 * MiB, WS_STAT2 = 14 * MiB, WS_STAT3 = 18 * MiB, WS_DIAG = 22 * MiB, WS_PB = 24 * MiB;
constexpr size_t WS_WIN = 32 * MiB, WS_WGU = 256 * MiB, WS_WDOWN = 428 * MiB, WS_WA = 514 * MiB, WS_WB = 546 * MiB, WS_WO = 578 * MiB, WS_WPG = 610 * MiB, WS_WPP = 642 * MiB;
constexpr size_t WS_H = 648 * MiB;
constexpr size_t WS_ACT = 776 * MiB, ACT_STRIDE = 128 * MiB;
constexpr size_t WS_GU = WS_ACT, WS_GV = WS_ACT + ACT_STRIDE, WS_Q = WS_ACT + 2 * ACT_STRIDE, WS_K = WS_ACT + 3 * ACT_STRIDE, WS_V = WS_ACT + 4 * ACT_STRIDE, WS_SA = WS_ACT + 5 * ACT_STRIDE, WS_SB = WS_ACT + 6 * ACT_STRIDE;
constexpr size_t WS_X3 = WS_SA;
constexpr size_t WS_WIN8 = WS_WIN + (size_t)5 * D_MODEL * D_MODEL * 2;
constexpr size_t WS_H8 = WS_WGU;
constexpr size_t WS_X8 = WS_SB;
constexpr size_t WS_MERGED = WS_GV, WS_PP = WS_K, WS_HID = WS_ACT;
constexpr size_t WS_END = WS_ACT + 7 * ACT_STRIDE;
static_assert(WS_WPP + 2 * MiB <= WS_H && WS_H + 128 * MiB <= WS_ACT && (size_t)M_TOK * D_FF * 2 <= 3 * ACT_STRIDE, "d_ws map");
constexpr int CW_BAR = 4096;
constexpr int CW_ATTQ = 8192;
constexpr int CW_KN = 12288;
static_assert((CW_KN + 2 * 16 * 2 * 4) * 4 <= (int)CTL_ZERO_BYTES && (CW_ATTQ + 1024) <= CW_KN && (CW_BAR + 3456) <= CW_ATTQ, "control words inside the per-call memset");
__device__ const unsigned short ATT_ITEMS[2824] = {767,1983,765,2048,1981,763,1979,2056,761,1977,2064,698,700,702,2072,696,759,1975,2080,694,757,2088,1973,692,755,2096,1971,690,753,2104,1969,688,2112,751,1967,686,2120,749,1965,684,2128,747,1963,2136,682,745,1961,2144,680,743,2152,1959,678,741,2160,1957,676,739,2168,1955,674,2176,737,1953,672,2184,735,1951,670,2192,733,1949,2200,542,544,546,2208,548,550,552,2216,554,556,2224,558,560,562,2232,564,566,2240,568,570,572,2248,574,540,668,2256,731,1947,2264,538,666,729,2272,1945,536,664,2280,727,1943,2288,534,662,725,2296,1941,469,471,2304,473,475,2312,477,479,481,2320,483,485,487,2328,489,491,2336,493,495,497,2344,499,501,2352,503,505,507,2360,509,511,532,2368,660,467,2376,723,1939,530,2384,658,465,721,2392,1937,528,2400,656,463,719,2408,1935,526,654,2416,461,717,2424,1933,524,652,2432,459,715,2440,1931,331,333,2448,335,337,339,2456,341,343,2464,345,347,349,2472,351,353,355,2480,357,359,2488,361,363,365,2496,367,369,371,2504,373,375,2512,377,379,381,2520,383,522,2528,650,329,457,2536,713,1929,520,2544,648,327,2552,455,711,1927,2560,518,646,325,2568,453,709,2576,1925,132,134,2584,136,138,140,2592,142,144,2600,146,148,150,2608,152,154,156,2616,158,160,2624,162,164,166,2632,168,170,2640,172,174,176,2648,178,180,182,2656,184,186,2664,188,190,516,2672,644,323,451,2680,707,1923,2688,2,4,6,2696,8,10,12,2704,14,16,2712,18,20,22,2720,24,26,2728,28,30,32,2736,34,36,38,2744,40,42,2752,44,46,48,2760,50,52,54,2768,56,58,2776,60,62,130,2784,514,642,321,2792,449,705,2800,1921,0,128,2808,512,640,2816,831,2047,829,2049,2045,827,2043,2057,825,2041,2065,1722,1724,1726,2073,1720,823,2039,2081,1718,821,2089,2037,1716,819,2097,2035,1714,817,2105,2033,1712,2113,815,2031,1710,2121,813,2029,1708,2129,811,2027,2137,1706,809,2025,2145,1704,807,2153,2023,1702,805,2161,2021,1700,803,2169,2019,1698,2177,801,2017,1696,2185,799,2015,1694,2193,797,2013,2201,1566,1568,1570,2209,1572,1574,1576,2217,1578,1580,2225,1582,1584,1586,2233,1588,1590,2241,1592,1594,1596,2249,1598,1564,1692,2257,795,2011,2265,1562,1690,793,2273,2009,1560,1688,2281,791,2007,2289,1558,1686,789,2297,2005,1493,1495,2305,1497,1499,2313,1501,1503,1505,2321,1507,1509,1511,2329,1513,1515,2337,1517,1519,1521,2345,1523,1525,2353,1527,1529,1531,2361,1533,1535,1556,2369,1684,787,2377,1491,2003,1554,2385,1682,785,1489,2393,2001,1552,2401,1680,783,1487,2409,1999,1550,1678,2417,781,1485,2425,1997,1548,1676,2433,779,1483,2441,1995,1355,1357,2449,1359,1361,1363,2457,1365,1367,2465,1369,1371,1373,2473,1375,1377,1379,2481,1381,1383,2489,1385,1387,1389,2497,1391,1393,1395,2505,1397,1399,2513,1401,1403,1405,2521,1407,1546,2529,1674,777,1353,2537,1481,1993,1544,2545,1672,775,2553,1351,1479,1991,2561,1542,1670,773,2569,1349,1477,2577,1989,1156,1158,2585,1160,1162,1164,2593,1166,1168,2601,1170,1172,1174,2609,1176,1178,1180,2617,1182,1184,2625,1186,1188,1190,2633,1192,1194,2641,1196,1198,1200,2649,1202,1204,1206,2657,1208,1210,2665,1212,1214,1540,2673,1668,771,1347,2681,1475,1987,2689,1026,1028,1030,2697,1032,1034,1036,2705,1038,1040,2713,1042,1044,1046,2721,1048,1050,2729,1052,1054,1056,2737,1058,1060,1062,2745,1064,1066,2753,1068,1070,1072,2761,1074,1076,1078,2769,1080,1082,2777,1084,1086,1154,2785,1538,1666,769,2793,1345,1473,2801,1985,1024,1152,2809,1536,1664,2817,895,1982,893,2050,1980,891,1978,2058,889,697,2066,699,701,703,2074,1976,695,887,2082,1974,693,2090,885,1972,691,2098,883,1970,689,2106,881,1968,2114,687,879,1966,2122,685,877,1964,2130,683,875,2138,1962,681,873,2146,1960,679,2154,871,1958,677,2162,869,1956,675,2170,867,1954,2178,673,865,1952,2186,671,863,1950,2194,669,861,2202,541,543,545,2210,547,549,551,2218,553,555,2226,557,559,561,2234,563,565,2242,567,569,571,2250,573,575,1948,2258,539,667,2266,859,1946,537,2274,665,857,1944,2282,535,663,2290,855,1942,533,2298,661,853,468,2306,470,472,2314,474,476,478,2322,480,482,484,2330,486,488,2338,490,492,494,2346,496,498,2354,500,502,504,2362,506,508,510,2370,1940,531,2378,659,851,466,2386,1938,529,657,2394,849,464,2402,1936,527,655,2410,847,462,1934,2418,525,653,2426,845,460,1932,2434,523,651,2442,843,330,332,2450,334,336,338,2458,340,342,2466,344,346,348,2474,350,352,354,2482,356,358,2490,360,362,364,2498,366,368,370,2506,372,374,2514,376,378,380,2522,382,458,2530,1930,521,649,2538,841,328,456,2546,1928,519,2554,647,839,326,2562,454,1926,517,2570,645,837,2578,133,135,137,2586,139,141,143,2594,145,147,2602,149,151,153,2610,155,157,159,2618,161,163,2626,165,167,169,2634,171,173,2642,175,177,179,2650,181,183,185,2658,187,189,2666,191,324,452,2674,1924,131,515,2682,643,835,2690,3,5,7,2698,9,11,13,2706,15,17,2714,19,21,23,2722,25,27,2730,29,31,33,2738,35,37,39,2746,41,43,2754,45,47,49,2762,51,53,55,2770,57,59,2778,61,63,322,2786,450,1922,1,2794,129,513,2802,641,833,320,2810,448,1920,2818,959,2046,957,2051,2044,955,2042,2059,953,1721,2067,1723,1725,1727,2075,2040,951,1719,2083,2038,949,2091,1717,2036,947,2099,1715,2034,945,2107,1713,2032,2115,943,1711,2030,2123,941,1709,2028,2131,939,1707,2139,2026,937,1705,2147,2024,935,2155,1703,2022,933,2163,1701,2020,931,2171,1699,2018,2179,929,1697,2016,2187,927,1695,2014,2195,925,1693,2203,1565,1567,1569,2211,1571,1573,1575,2219,1577,1579,2227,1581,1583,1585,2235,1587,1589,2243,1591,1593,1595,2251,1597,1599,2012,2259,923,1563,2267,1691,2010,921,2275,1561,1689,2008,2283,919,1559,2291,1687,2006,917,2299,1557,1685,1492,2307,1494,1496,2315,1498,1500,1502,2323,1504,1506,1508,2331,1510,1512,2339,1514,1516,1518,2347,1520,1522,2355,1524,1526,1528,2363,1530,1532,1534,2371,2004,915,2379,1555,1683,1490,2387,2002,913,1553,2395,1681,1488,2403,2000,911,1551,2411,1679,1486,1998,2419,909,1549,2427,1677,1484,1996,2435,907,1547,2443,1675,1354,1356,2451,1358,1360,1362,2459,1364,1366,2467,1368,1370,1372,2475,1374,1376,1378,2483,1380,1382,2491,1384,1386,1388,2499,1390,1392,1394,2507,1396,1398,2515,1400,1402,1404,2523,1406,1482,2531,1994,905,1545,2539,1673,1352,1480,2547,1992,903,2555,1543,1671,1350,2563,1478,1990,901,2571,1541,1669,2579,1157,1159,1161,2587,1163,1165,1167,2595,1169,1171,2603,1173,1175,1177,2611,1179,1181,1183,2619,1185,1187,2627,1189,1191,1193,2635,1195,1197,2643,1199,1201,1203,2651,1205,1207,1209,2659,1211,1213,2667,1215,1348,1476,2675,1988,899,1155,2683,1539,1667,2691,1027,1029,1031,2699,1033,1035,1037,2707,1039,1041,2715,1043,1045,1047,2723,1049,1051,2731,1053,1055,1057,2739,1059,1061,1063,2747,1065,1067,2755,1069,1071,1073,2763,1075,1077,1079,2771,1081,1083,2779,1085,1087,1346,2787,1474,1986,897,2795,1025,1153,2803,1537,1665,1344,2811,1472,1984,2819,1023,766,1022,2052,1021,764,1020,2060,1019,762,2068,1018,1017,760,2076,1016,1015,758,2084,1014,1013,2092,756,1012,1011,2100,754,1010,1009,2108,752,1008,2116,1007,750,1006,2124,1005,748,1004,2132,1003,746,2140,1002,1001,617,2148,619,621,2156,623,625,627,2164,629,631,633,2172,635,637,2180,639,744,1000,2188,615,999,742,2196,998,613,2204,997,740,996,2212,611,995,738,2220,994,609,2228,993,736,992,2236,607,991,2244,734,990,605,2252,989,732,988,2260,603,987,2268,730,986,601,2276,985,728,984,2284,599,983,2292,726,982,597,2300,981,724,980,2308,595,979,2316,722,978,593,2324,977,720,976,2332,591,975,2340,400,402,404,2348,406,408,2356,410,412,414,2364,416,418,420,2372,422,424,2380,426,428,430,2388,432,434,436,2396,438,440,2404,442,444,446,2412,398,718,974,2420,589,973,2428,396,716,972,2436,587,971,2444,394,714,970,2452,585,969,392,2460,712,968,2468,264,266,268,2476,270,272,274,2484,276,278,2492,280,282,284,2500,286,288,290,2508,292,294,2516,296,298,300,2524,302,304,2532,306,308,310,2540,312,314,316,2548,318,583,2556,967,262,390,2564,710,966,198,2572,200,202,2580,204,206,208,2588,210,212,214,2596,216,218,2604,220,222,224,2612,226,228,230,2620,232,234,2628,236,238,240,2636,242,244,2644,246,248,250,2652,252,254,581,2660,965,196,2668,260,388,708,2676,964,579,963,2684,68,70,2692,72,74,76,2700,78,80,82,2708,84,86,2716,88,90,92,2724,94,96,2732,98,100,102,2740,104,106,108,2748,110,112,2756,114,116,118,2764,120,122,124,2772,126,66,2780,194,258,386,2788,706,962,577,2796,961,64,2804,192,256,384,2812,704,960,2820,1791,830,1790,2053,1789,828,1788,2061,1787,826,2069,1786,1785,824,2077,1784,1783,822,2085,1782,1781,2093,820,1780,1779,2101,818,1778,1777,2109,816,1776,2117,1775,814,1774,2125,1773,812,1772,2133,1771,810,2141,1770,1769,808,2149,1641,1643,2157,1645,1647,1649,2165,1651,1653,1655,2173,1657,1659,2181,1661,1663,1768,2189,1639,1767,806,2197,1766,1637,2205,1765,804,1764,2213,1635,1763,802,2221,1762,1633,2229,1761,800,1760,2237,1631,1759,2245,798,1758,1629,2253,1757,796,1756,2261,1627,1755,2269,794,1754,1625,2277,1753,792,1752,2285,1623,1751,2293,790,1750,1621,2301,1749,788,1748,2309,1619,1747,2317,786,1746,1617,2325,1745,784,1744,2333,1615,1743,2341,1424,1426,1428,2349,1430,1432,2357,1434,1436,1438,2365,1440,1442,1444,2373,1446,1448,2381,1450,1452,1454,2389,1456,1458,1460,2397,1462,1464,2405,1466,1468,1470,2413,782,1422,1742,2421,1613,1741,2429,780,1420,1740,2437,1611,1739,2445,778,1418,1738,2453,1609,1737,776,2461,1416,1736,2469,1288,1290,1292,2477,1294,1296,1298,2485,1300,1302,2493,1304,1306,1308,2501,1310,1312,1314,2509,1316,1318,2517,1320,1322,1324,2525,1326,1328,2533,1330,1332,1334,2541,1336,1338,1340,2549,1342,1607,2557,1735,774,1286,2565,1414,1734,1222,2573,1224,1226,2581,1228,1230,1232,2589,1234,1236,1238,2597,1240,1242,2605,1244,1246,1248,2613,1250,1252,1254,2621,1256,1258,2629,1260,1262,1264,2637,1266,1268,2645,1270,1272,1274,2653,1276,1278,1605,2661,1733,772,2669,1220,1284,1412,2677,1732,1603,1731,2685,1092,1094,2693,1096,1098,1100,2701,1102,1104,1106,2709,1108,1110,2717,1112,1114,1116,2725,1118,1120,2733,1122,1124,1126,2741,1128,1130,1132,2749,1134,1136,2757,1138,1140,1142,2765,1144,1146,1148,2773,1150,770,2781,1090,1218,1282,2789,1410,1730,1601,2797,1729,768,2805,1088,1216,1280,2813,1408,1728,2821,1855,894,1854,2054,1853,892,1852,2062,1851,890,2070,1850,1849,888,2078,1848,1847,886,2086,1846,1845,2094,884,1844,1843,2102,882,1842,1841,2110,880,1840,2118,1839,878,1838,2126,1837,876,1836,2134,1835,874,2142,1834,1833,616,2150,618,620,2158,622,624,626,2166,628,630,632,2174,634,636,2182,638,872,1832,2190,1831,614,870,2198,1830,1829,2206,612,868,1828,2214,1827,610,866,2222,1826,1825,2230,608,864,1824,2238,1823,606,2246,862,1822,1821,2254,604,860,1820,2262,1819,602,2270,858,1818,1817,2278,600,856,1816,2286,1815,598,2294,854,1814,1813,2302,596,852,1812,2310,1811,594,2318,850,1810,1809,2326,592,848,1808,2334,1807,399,2342,401,403,405,2350,407,409,2358,411,413,415,2366,417,419,421,2374,423,425,2382,427,429,431,2390,433,435,437,2398,439,441,2406,443,445,447,2414,590,846,1806,2422,397,1805,2430,588,844,1804,2438,395,1803,2446,586,842,1802,2454,393,1801,584,2462,840,1800,2470,265,267,269,2478,271,273,275,2486,277,279,2494,281,283,285,2502,287,289,291,2510,293,295,2518,297,299,301,2526,303,305,2534,307,309,311,2542,313,315,317,2550,319,263,2558,391,1799,582,2566,838,1798,197,2574,199,201,2582,203,205,207,2590,209,211,213,2598,215,217,2606,219,221,223,2614,225,227,229,2622,231,233,2630,235,237,239,2638,241,243,2646,245,247,249,2654,251,253,255,2662,261,389,2670,1797,580,836,2678,1796,195,259,2686,387,1795,2694,67,69,71,2702,73,75,77,2710,79,81,2718,83,85,87,2726,89,91,2734,93,95,97,2742,99,101,103,2750,105,107,2758,109,111,113,2766,115,117,119,2774,121,123,2782,125,127,578,2790,834,1794,65,2798,193,257,2806,385,1793,576,2814,832,1792,2822,1919,958,1918,2055,1917,956,1916,2063,1915,954,2071,1914,1913,952,2079,1912,1911,950,2087,1910,1909,2095,948,1908,1907,2103,946,1906,1905,2111,944,1904,2119,1903,942,1902,2127,1901,940,1900,2135,1899,938,2143,1898,1897,936,2151,1640,1642,2159,1644,1646,1648,2167,1650,1652,1654,2175,1656,1658,2183,1660,1662,1896,2191,1895,934,1638,2199,1894,1893,2207,932,1636,1892,2215,1891,930,1634,2223,1890,1889,2231,928,1632,1888,2239,1887,926,2247,1630,1886,1885,2255,924,1628,1884,2263,1883,922,2271,1626,1882,1881,2279,920,1624,1880,2287,1879,918,2295,1622,1878,1877,2303,916,1620,1876,2311,1875,914,2319,1618,1874,1873,2327,912,1616,1872,2335,1871,1423,2343,1425,1427,1429,2351,1431,1433,2359,1435,1437,1439,2367,1441,1443,1445,2375,1447,1449,2383,1451,1453,1455,2391,1457,1459,1461,2399,1463,1465,2407,1467,1469,1471,2415,910,1614,1870,2423,1421,1869,2431,908,1612,1868,2439,1419,1867,2447,906,1610,1866,2455,1417,1865,904,2463,1608,1864,2471,1289,1291,1293,2479,1295,1297,1299,2487,1301,1303,2495,1305,1307,1309,2503,1311,1313,1315,2511,1317,1319,2519,1321,1323,1325,2527,1327,1329,2535,1331,1333,1335,2543,1337,1339,1341,2551,1343,1287,2559,1415,1863,902,2567,1606,1862,1221,2575,1223,1225,2583,1227,1229,1231,2591,1233,1235,1237,2599,1239,1241,2607,1243,1245,1247,2615,1249,1251,1253,2623,1255,1257,2631,1259,1261,1263,2639,1265,1267,2647,1269,1271,1273,2655,1275,1277,1279,2663,1285,1413,2671,1861,900,1604,2679,1860,1219,1283,2687,1411,1859,2695,1091,1093,1095,2703,1097,1099,1101,2711,1103,1105,2719,1107,1109,1111,2727,1113,1115,2735,1117,1119,1121,2743,1123,1125,1127,2751,1129,1131,2759,1133,1135,1137,2767,1139,1141,1143,2775,1145,1147,2783,1149,1151,898,2791,1602,1858,1089,2799,1217,1281,2807,1409,1857,896,2815,1600,1856,2823};
__device__ const unsigned short ATT_OFF[9] = {0,353,706,1059,1412,1765,2118,2471,2824};


constexpr int RING_OFF = 0, RING_BYTES = 131072, ATT_SCR_OFF = RING_BYTES, LDSCTL_OFF = RING_BYTES + 2048, MISC_OFF = LDSCTL_OFF + 320, ATT_Q_OFF = MISC_OFF + 256, RS_OFF = MISC_OFF + 512, LDS_BYTES = 147456;
constexpr int NWAVES = 8;

#define XB_TMO      128
#define XB_XCNT(j)  (256  + 64 * (j))
#define XB_XSUB(j)  (1280 + 64 * (j))
#define XB_XGEN(j)  (2304 + 64 * (j))
#define XB_TOP      3328
#define XB_TOPGEN   3392
#define XCD_BAR_WORDS 3456
#define XB_SPIN_CAP (1u << 22)
__device__ __forceinline__ unsigned xb_ld(unsigned* p)              { return __hip_atomic_load(p, __ATOMIC_RELAXED, __HIP_MEMORY_SCOPE_AGENT); }
__device__ __forceinline__ unsigned xb_add(unsigned* p, unsigned v) { return __hip_atomic_fetch_add(p, v, __ATOMIC_RELAXED, __HIP_MEMORY_SCOPE_AGENT); }
__device__ __forceinline__ unsigned xb_xcc_id() { return (unsigned)__builtin_amdgcn_s_getreg((3 << 11) | 20) & 0xFu; }
#define XB_SPIN(cond, bar) do { unsigned _sp = 0; while (cond) { __builtin_amdgcn_s_sleep(1); \
    if ((++_sp & 255u) == 0u) { if (xb_ld(&(bar)[XB_TMO])) break; if (_sp > XB_SPIN_CAP) { atomicAdd(&(bar)[XB_TMO], 1u); break; } } } } while (0)
struct XcdBarrier { unsigned* bar; unsigned x; volatile LAS unsigned* st; };
__device__ __forceinline__ XcdBarrier xcd_barrier_post(unsigned* bar, volatile LAS unsigned* st) {
    XcdBarrier b; b.bar = bar; b.x = xb_xcc_id(); b.st = st;
    if (threadIdx.x == 0) (void)xb_add(&bar[XB_XCNT(b.x)], 1u);
    return b;
}
__device__ __forceinline__ void xcd_barrier_complete(unsigned* bar, unsigned x, unsigned& nloc, unsigned& nx) {
    const unsigned G = gridDim.x * gridDim.y * gridDim.z;
    unsigned sum, cnt, mine, sp = 0u;
    for (;;) {
        sum = 0u; cnt = 0u; mine = 0u;
#pragma unroll
        for (unsigned j = 0; j < 16; ++j) { const unsigned c = xb_ld(&bar[XB_XCNT(j)]); sum += c; cnt += (c > 0u) ? 1u : 0u; mine = (j == x) ? c : mine; }
        if (sum == G) break;
        __builtin_amdgcn_s_sleep(1);
        if ((++sp & 255u) == 0u) { if (xb_ld(&bar[XB_TMO])) break; if (sp > XB_SPIN_CAP) { atomicAdd(&bar[XB_TMO], 1u); break; } }
    }
    nloc = mine > 0u ? mine : 1u; nx = cnt > 0u ? cnt : 1u;
}
__device__ __forceinline__ void xcd_barrier(const XcdBarrier& b, const int wave) {
    asm volatile("s_waitcnt vmcnt(0)" ::: "memory");
    __syncthreads();
    if (wave == 0 && lane_id() == 0) {
        unsigned* bar = b.bar;
        __builtin_amdgcn_s_waitcnt(0);
        unsigned nloc = b.st[0], nx = b.st[1];
        if (nloc == 0u) { xcd_barrier_complete(bar, b.x, nloc, nx); b.st[0] = nloc; b.st[1] = nx; }
        const unsigned old = xb_add(&bar[XB_XSUB(b.x)], 1u);
        const unsigned gen = old / nloc;
        if (old + 1u == (gen + 1u) * nloc) {
            __builtin_amdgcn_fence(__ATOMIC_RELEASE, "agent");
            asm volatile("s_waitcnt vmcnt(0)" ::: "memory");
            const unsigned og = xb_add(&bar[XB_TOP], 1u);
            const unsigned tg = og / nx;
            if (og + 1u == (tg + 1u) * nx) xb_add(&bar[XB_TOPGEN], 1u);
            else XB_SPIN(xb_ld(&bar[XB_TOPGEN]) == tg, bar);
            __builtin_amdgcn_fence(__ATOMIC_ACQUIRE, "agent");
            xb_add(&bar[XB_XGEN(b.x)], 1u);
            asm volatile("s_waitcnt vmcnt(0)" ::: "memory");
        } else {
            XB_SPIN(xb_ld(&bar[XB_XGEN(b.x)]) == gen, bar);
            __builtin_amdgcn_fence(__ATOMIC_ACQUIRE, "agent");
            asm volatile("s_waitcnt vmcnt(0)" ::: "memory");
        }
    }
    __syncthreads();
}

template <bool NT> __device__ __forceinline__ void p0_load(f32x4 (&v)[8], const float* W, int N, int k0, int src0, int lane) {
    const int kr = lane >> 3, nc = (lane & 7) * 4;
#pragma unroll
    for (int i = 0; i < 8; ++i) { const GAS f32x4* p = (const GAS f32x4*)(W + (size_t)(k0 + 8 * i + kr) * N + src0 + nc); v[i] = NT ? __builtin_nontemporal_load(p) : *p; }
}
template <bool NTS, bool F8 = false> __device__ __forceinline__ void p0_store(const f32x4 (&v)[8], int K, bf16_t* WT, const float* ksc, LAS float* scr, int k0, int n0, int lane) {
    const int kr = lane >> 3, nc = (lane & 7) * 4;
#pragma unroll
    for (int i = 0; i < 8; ++i) { const int kk = 8 * i + kr; const float sc = (ksc ? ksc[k0 + kk] : 1.f) * (F8 ? F8_SW : 1.f); LAS float* s = scr + kk * 33 + nc;
        s[0] = v[i][0] * sc; s[1] = v[i][1] * sc; s[2] = v[i][2] * sc; s[3] = v[i][3] * sc; }
    asm volatile("s_waitcnt lgkmcnt(0)" ::: "memory");
    const int c = lane & 7;
#pragma unroll
    for (int j = 0; j < 4; ++j) { const int n = (lane >> 3) + 8 * j; const LAS float* s = scr + (8 * c) * 33 + n;
        if constexpr (F8) { u32x2 o; o.x = pk_fp8x4(s[0 * 33], s[1 * 33], s[2 * 33], s[3 * 33]); o.y = pk_fp8x4(s[4 * 33], s[5 * 33], s[6 * 33], s[7 * 33]);
            *(GAS u32x2*)((unsigned char*)WT + (size_t)(n0 + n) * K + k0 + 8 * c) = o; }
        else {
        u32x4 o; o.x = cvt_pk_bf16(s[0 * 33], s[1 * 33]); o.y = cvt_pk_bf16(s[2 * 33], s[3 * 33]); o.z = cvt_pk_bf16(s[4 * 33], s[5 * 33]); o.w = cvt_pk_bf16(s[6 * 33], s[7 * 33]);
        if (NTS) __builtin_nontemporal_store(o, (GAS u32x4*)(WT + (size_t)(n0 + n) * K + k0 + 8 * c)); else *(GAS u32x4*)(WT + (size_t)(n0 + n) * K + k0 + 8 * c) = o; } }
    asm volatile("s_waitcnt lgkmcnt(0)" ::: "memory");
}
template <bool NTS, bool F8 = false> __device__ __forceinline__ void p0_item(const float* W, int N, int K, bf16_t* WT, const float* ksc, LAS float* scr, int k0, int n0, int src0, int lane) {
    f32x4 v[8]; p0_load<true>(v, W, N, k0, src0, lane); p0_store<NTS, F8>(v, K, WT, ksc, scr, k0, n0, lane);
}
template <int GU  > __device__ __forceinline__ void p0_matrix(const float* W, int K, int N, bf16_t* WT, const float* ksc, LAS float* scr, int gw, int NGW, int& base, int lane, bf16_t* WT8 = nullptr) {
    const int nblk = N / 32, items = (K / 64) * nblk;
    int first = (gw - (base % NGW) + NGW) % NGW;
    for (int it = first; it < items; it += NGW) { const int kb = it / nblk, nb = it % nblk, n0 = nb * 32;
        int src0 = n0; if (GU == 1) { const int pn = n0 >> 8, bj = (n0 >> 7) & 1, ii = n0 & 127; src0 = bj * D_FF + pn * 128 + ii; }
        if (GU == 2 && n0 >= 5 * D_MODEL) { const int r = n0 - 5 * D_MODEL, jt = r >> 8, bj = (r >> 7) & 1, ii = r & 127; src0 = 5 * D_MODEL + bj * D_MODEL + jt * 128 + ii;
            p0_item<false, true>(W, N, K, WT8, ksc, scr, kb * 64, r, src0, lane); continue; }
        p0_item<(GU != 2)>(W, N, K, WT, ksc, scr, kb * 64, n0, src0, lane); }
    base += items;
}

__device__ __forceinline__ void fill_row_scale(LAS float* rs, const float* stat, int pm, int wave, int lane) {
#pragma unroll 8
    for (int i = 0; i < 32; ++i) { const int r = wave * 32 + i; const float s = wave_sum(stat[((size_t)pm * 256 + r) * 64 + lane]); if (lane == 0) rs[r] = rsqrtf(s * (1.f / D_MODEL) + RMS_EPS); }
    asm volatile("s_waitcnt lgkmcnt(0)" ::: "memory"); __syncthreads();
}
struct Args { const float* in[24]; float* out; unsigned char* ws; int ph_lo, ph_hi; };
enum { I_X = 0, I_P, I_GMIX, I_WIN, I_BGATE, I_LNVG, I_LNVB, I_WS, I_BS, I_LQ1, I_LK1, I_LQ2, I_LK2, I_SUBLN, I_WA, I_WB, I_WO, I_GFFN, I_WGU, I_WDOWN, I_GPLE, I_WPG, I_WPP, I_GFINAL };
constexpr int N_PHASES = 10;

typedef __attribute__((address_space(4))) const unsigned char* kptr_t;
__device__ __forceinline__ const float* karg_in(int i) { kptr_t ka = (kptr_t)__builtin_amdgcn_kernarg_segment_ptr(); asm volatile("" : "+s"(ka)); return *(const float* const __attribute__((address_space(4)))*)(ka + 8 * i); }
#define AIN(i) karg_in(i)
constexpr int CV_GU = (D_MODEL / 64) * (2 * D_FF / 32) / 128, CV_DOWN = (D_FF / 64) * (D_MODEL / 32) / 128, CV_SQ = (D_MODEL / 64) * (D_MODEL / 32) / 128, CV_PP = (PLE_DIM / 64) * (D_MODEL / 32) / 128;
constexpr int CV_CHUNKS = CV_GU + CV_DOWN + 4 * CV_SQ + CV_PP;
static_assert((D_MODEL / 64) * (2 * D_FF / 32) % 128 == 0 && (D_FF / 64) * (D_MODEL / 32) % 128 == 0 && (PLE_DIM / 64) * (D_MODEL / 32) % 128 == 0 && CV_CHUNKS == 776, "conversion chunks");
__device__ __forceinline__ void cv_load(f32x4 (&v)[8], float& kv, const float* W, int N, int k0, int src0, const float* kp, int lane) {
    const int kr = lane >> 3, nc = (lane & 7) * 4;
    const float* p = W + (size_t)(k0 + kr) * N + src0 + nc;
#pragma unroll
    for (int i = 0; i < 8; ++i) { v[i] = __builtin_nontemporal_load((const GAS f32x4*)p); p += (size_t)8 * N; }
    kv = *(const GAS float*)kp;
}
template <bool F8> __device__ __forceinline__ void cv_store(const f32x4 (&v)[8], float kv, int K, bf16_t* WT, LAS float* scr, int k0, int n0, int lane) {
    const int kr = lane >> 3, nc = (lane & 7) * 4;
#pragma unroll
    for (int i = 0; i < 8; ++i) { const int kk = 8 * i + kr; const float sc = __builtin_bit_cast(float, __builtin_amdgcn_ds_bpermute(kk * 4, __builtin_bit_cast(int, kv))); LAS float* s = scr + kk * 33 + nc;
        s[0] = v[i][0] * sc; s[1] = v[i][1] * sc; s[2] = v[i][2] * sc; s[3] = v[i][3] * sc; }
    asm volatile("s_waitcnt lgkmcnt(0)" ::: "memory");
    const int c = lane & 7;
#pragma unroll
    for (int j = 0; j < 4; ++j) { const int n = (lane >> 3) + 8 * j; const LAS float* s = scr + (8 * c) * 33 + n;
        if constexpr (F8) {
            u32x2 o; o.x = pk_fp8x4(s[0 * 33], s[1 * 33], s[2 * 33], s[3 * 33]); o.y = pk_fp8x4(s[4 * 33], s[5 * 33], s[6 * 33], s[7 * 33]);
            unsigned char* dst = (unsigned char*)WT + (size_t)(n0 + n) * K + k0 + 8 * c;
            asm volatile("global_store_dwordx2 %0, %1, off" :: "v"(dst), "v"(o) : "memory");
        } else {
        u32x4 o; o.x = cvt_pk_bf16(s[0 * 33], s[1 * 33]); o.y = cvt_pk_bf16(s[2 * 33], s[3 * 33]); o.z = cvt_pk_bf16(s[4 * 33], s[5 * 33]); o.w = cvt_pk_bf16(s[6 * 33], s[7 * 33]);
        bf16_t* dst = WT + (size_t)(n0 + n) * K + k0 + 8 * c;
        asm volatile("global_store_dwordx4 %0, %1, off" :: "v"(dst), "v"(o) : "memory"); } }
    asm volatile("s_waitcnt lgkmcnt(0)" ::: "memory");
}
template <bool F8> __device__ __forceinline__ void conv_body(int c, const float* W, const float* ksc, bf16_t* WT, int K, int N, int gu, LAS float* scr, int wave, int lane) {
    const bool has = ksc != nullptr;
    const int nblk = N / 32; int it = c * 128 + wave;
#define CV_DECODE(it_, k0_, n0_, s0_) const int k0_ = ((it_) / nblk) * 64, n0_ = ((it_) % nblk) * 32; int s0_ = n0_; if (gu) { const int pn = n0_ >> 8, bj = (n0_ >> 7) & 1, ii = n0_ & 127; s0_ = bj * D_FF + pn * 128 + ii; }
#define CV_LD(v, q, itx) do { CV_DECODE(itx, k0, n0, s0); (void)n0; cv_load(v, q, W, N, k0, s0, has ? ksc + k0 + lane : W, lane); } while (0)
#define CV_ST(v, q, itx, n) do { CV_DECODE(itx, k0, n0, s0); (void)s0; cv_store<F8>(v, (has ? q : 1.f) * (F8 ? F8_SW : 1.f), K, WT, scr, k0, n0, lane); } while (0)
    f32x4 v0[8], v1[8], v2[8], v3[8]; float q0, q1, q2, q3;
    CV_LD(v0, q0, it); CV_LD(v1, q1, it + 8); CV_LD(v2, q2, it + 16);
#pragma unroll
    for (int j = 0; j < 16; j += 4) {
        CV_LD(v3, q3, it + 24);
        CV_ST(v0, q0, it, 27);
        if (j + 4 < 16) { CV_LD(v0, q0, it + 32); CV_ST(v1, q1, it + 8, 27); CV_LD(v1, q1, it + 40); CV_ST(v2, q2, it + 16, 27); CV_LD(v2, q2, it + 48); CV_ST(v3, q3, it + 24, 27); }
        else { CV_ST(v1, q1, it + 8, 18); CV_ST(v2, q2, it + 16, 9); CV_ST(v3, q3, it + 24, 0); }
        it += 32;
    }
#undef CV_DECODE
#undef CV_LD
#undef CV_ST
}
__device__ __forceinline__ void conv_chunk(int c, unsigned char* ws, LAS float* scr, int wave, int lane) {
    const float* W; const float* ksc = nullptr; bf16_t* WT; int K, N, gu = 0; bool f8 = false;
    if (c < CV_GU) { W = AIN(I_WGU); ksc = AIN(I_GFFN); WT = (bf16_t*)(ws + WS_WGU); K = D_MODEL; N = 2 * D_FF; gu = 1; }
    else if ((c -= CV_GU) < CV_DOWN) { W = AIN(I_WDOWN); WT = (bf16_t*)(ws + WS_WDOWN); K = D_FF; N = D_MODEL; }
    else if ((c -= CV_DOWN) < 4 * CV_SQ) { const int m = c / CV_SQ; c -= m * CV_SQ; W = AIN(m < 3 ? I_WA + m : I_WPG); if (m == 3) { ksc = AIN(I_GPLE); f8 = true; } WT = (bf16_t*)(ws + WS_WA + (size_t)m * (WS_WB - WS_WA)); K = D_MODEL; N = D_MODEL; }
    else { c -= 4 * CV_SQ; W = AIN(I_WPP); WT = (bf16_t*)(ws + WS_WPP); K = PLE_DIM; N = D_MODEL; }
    if (f8) conv_body<true>(c, W, ksc, WT, K, N, gu, scr, wave, lane);
    else conv_body<false>(c, W, ksc, WT, K, N, gu, scr, wave, lane);
}
static_assert(WS_WB - WS_WA == WS_WO - WS_WB && WS_WO - WS_WB == WS_WPG - WS_WO && I_WB == I_WA + 1 && I_WO == I_WA + 2, "the four square weights are addressed by index");
__global__ void __launch_bounds__(NWAVES * 64, 2) mk_fwd(Args args) {
    extern __shared__ __attribute__((aligned(16))) unsigned char lds_raw[];
    LAS unsigned char* lds = (LAS unsigned char*)lds_raw;
    volatile LAS unsigned* MISC = (volatile LAS unsigned*)(lds + MISC_OFF);
    const int wave = __builtin_amdgcn_readfirstlane((int)threadIdx.x >> 6);
#define LANE_HERE() int lane = lane_id(); asm volatile("" : "+v"(lane)); const int tid = wave * 64 + lane; (void)tid;
    const int G = gridDim.x; const int bx = blockIdx.x; const int vcu = (G % 8 == 0) ? (bx % 8) * (G / 8) + bx / 8 : bx;
    unsigned char* ws = args.ws;
    unsigned* ctl = (unsigned*)(ws + WS_CTL);
    for (int u = threadIdx.x; u < (LDS_BYTES - LDSCTL_OFF) / 4; u += NWAVES * 64) ((LAS unsigned*)(lds + LDSCTL_OFF))[u] = 0u;
    __syncthreads();
    const int lo = args.ph_lo, hi = args.ph_hi;
    XcdBarrier bar; bar.bar = ctl + CW_BAR; bar.x = 0; bar.st = nullptr;
    if (hi - lo > 1) bar = xcd_barrier_post(ctl + CW_BAR, MISC + 8);
#ifndef PHASE_MASK
#define PHASE_MASK 0x3ff
#endif
#define IN(k) ((((PHASE_MASK) >> (k)) & 1) && lo <= (k) && (k) < hi)
#define BOTH(k) (IN(k) && IN((k) + 1))
#ifndef REP_MASK
#define REP_MASK 0
#endif
#define NREP(k) ((((REP_MASK) >> (k)) & 1) ? 2 : 1)
#define WIN ((bf16_t*)(ws + WS_WIN))
#define WGU ((bf16_t*)(ws + WS_WGU))
#define WDOWN ((bf16_t*)(ws + WS_WDOWN))
#define WA ((bf16_t*)(ws + WS_WA))
#define WB ((bf16_t*)(ws + WS_WB))
#define WO ((bf16_t*)(ws + WS_WO))
#define WPG ((bf16_t*)(ws + WS_WPG))
#define WPP ((bf16_t*)(ws + WS_WPP))
#define HB ((bf16_t*)(ws + WS_H))
#define PB ((bf16_t*)(ws + WS_PB))
#define STATV ((float*)(ws + WS_STATV))
#define STAT1 ((float*)(ws + WS_STAT1))
#define STAT2 ((float*)(ws + WS_STAT2))
#define STAT3 ((float*)(ws + WS_STAT3))

    if (IN(0)) {
        LANE_HERE();
        LAS float* scr = (LAS float*)(lds + RING_OFF + wave * 16384);
#pragma unroll 1
        for (int rep = 0; rep < NREP(0); ++rep) {
        const int gw = vcu * NWAVES + wave, NGW = G * NWAVES; int base = 0;
        p0_matrix<2>(AIN(I_WIN), D_MODEL, IN_TOTAL, WIN, nullptr, scr, gw, NGW, base, lane, (bf16_t*)(ws + WS_WIN8));
        const float* gm = AIN(I_GMIX);
        for (int m = gw; m < M_TOK; m += NGW) {
            const GAS f32x4* xr = (const GAS f32x4*)(AIN(I_X) + (size_t)m * D_MODEL) + lane;
            f32x4 v[16]; float s = 0.f;
#pragma unroll
            for (int j = 0; j < 16; ++j) { v[j] = __builtin_nontemporal_load(xr + 64 * j); s += pg8::hsq4(v[j]); }
            const float rstd = rsqrtf(wave_sum(s) * (1.f / D_MODEL) + RMS_EPS);
            GAS u32x2* o8 = (GAS u32x2*)(HB + (size_t)m * D_MODEL) + lane; GAS unsigned* o4 = (GAS unsigned*)(ws + WS_H8 + (size_t)m * D_MODEL) + lane;
#pragma unroll
            for (int j = 0; j < 16; ++j) { const f32x4 gv = *((const GAS f32x4*)gm + lane + 64 * j); u32x2 w; const f32x4 hv = v[j] * rstd * gv, h8 = hv * F8_SA;
                w.x = cvt_pk_bf16(hv[0], hv[1]); w.y = cvt_pk_bf16(hv[2], hv[3]); o8[64 * j] = w; o4[64 * j] = pk_fp8x4(h8[0], h8[1], h8[2], h8[3]); }
        }
        { const size_t n4 = (size_t)M_TOK * PLE_DIM / 4; const GAS f32x4* src = (const GAS f32x4*)AIN(I_P); GAS u32x2* dst = (GAS u32x2*)PB;
          for (size_t i = (size_t)gw * 64 + lane; i < n4; i += (size_t)NGW * 64) { const f32x4 v = __builtin_nontemporal_load(src + i); u32x2 w; w.x = cvt_pk_bf16(v[0], v[1]); w.y = cvt_pk_bf16(v[2], v[3]); dst[i] = w; } }
        }
        if (BOTH(0)) xcd_barrier(bar, wave);
    }
    if (IN(1)) {
        pg8::Gemm g{HB, WIN, HB, WIN, M_TOK, 5 * D_MODEL, D_MODEL, D_MODEL, D_MODEL / 64}; pg8::StaticOrder S; S.init(M_TOK, 5 * D_MODEL, G, bx);
        pg8::EpiProj E{(bf16_t*)(ws + WS_ACT), STATV, ctl + CW_KN};
#ifdef PROBE_EPI
        { pg8::EpiProbe<PROBE_EPI> EP{(bf16_t*)(ws + WS_ACT)}; pg8::gemm_phase<pg8::EpiProbe<PROBE_EPI>, pg8::StaticOrder, true, true>(lds + RING_OFF, g, S, EP, wave); }
#endif
#pragma unroll 1
        for (int rep = 0; rep < NREP(1); ++rep)
        pg8::gemm_phase<pg8::EpiProj, pg8::StaticOrder, true, true>(lds + RING_OFF, g, S, E, wave);
        { const bf16_t* A8 = (const bf16_t*)(ws + WS_H8); const bf16_t* B8 = (const bf16_t*)(ws + WS_WIN8);
          pg8::Gemm g8{A8, B8, A8, B8, M_TOK, 2 * D_MODEL, D_MODEL / 2, D_MODEL / 2, D_MODEL / 128}; pg8::StaticOrder S8; S8.init(M_TOK, 2 * D_MODEL, G, bx);
          pg8::EpiGates E8{(bf16_t*)(ws + WS_ACT), AIN(I_BGATE)};
#if PROBE_NULLEPI & 4
          { pg8::EpiNull EN; pg8::gemm_phase<pg8::EpiNull, pg8::StaticOrder, true, true, true>(lds + RING_OFF, g8, S8, EN, wave); }
#endif
#pragma unroll 1
          for (int rep = 0; rep < NREP(1); ++rep)
          pg8::gemm_phase<pg8::EpiGates, pg8::StaticOrder, true, true, true>(lds + RING_OFF, g8, S8, E8, wave); }
        if (BOTH(1)) xcd_barrier(bar, wave);
    }
    if (IN(2)) {
        LANE_HERE();
        bf16_t* GU = (bf16_t*)(ws + WS_GU); const bf16_t* GV = (const bf16_t*)(ws + WS_GV);
        constexpr int TST = 272;
        LAS unsigned char* Tl = lds; LAS unsigned char* Wl = lds + 65536; LAS f32x2* stl = (LAS f32x2*)(lds + 65536 + 128 * TST);
        const int tvb = (int)(uintptr_t)(lds) + att::v_rd_base(lane) + (wave & 3) * 512 + (wave >> 2) * 16384;
        const int r32 = lane & 31, hi5 = lane >> 5;
        int cur_g = -1;
#pragma unroll 1
        for (int rep = 0; rep < NREP(2); ++rep)
#pragma unroll 1
        for (int ui = 0; ui * G + vcu < (M_TOK / CHUNK) * GROUPS; ++ui) {
            const int uid = ui * G + vcu, gq = (G % 16 == 0) ? (vcu & 15) : (uid & 15), cbk = (G % 16 == 0) ? ((vcu >> 4) + (G >> 4) * ui) : (uid >> 4); const size_t R0 = (size_t)cbk * CHUNK;
            bf16_t* YO = (NREP(2) == 2 && rep == 0) ? HB : GU;
            f32x4 sp[8];
            { const f32x4* p = (const f32x4*)(STATV + (R0 + (tid >> 2)) * 128 + (tid & 3) * 32);
#pragma unroll
              for (int i = 0; i < 8; ++i) sp[i] = p[i]; }
            u32x4 gvw[8];
            const int c8 = (tid & 31) * 8;
#pragma unroll
            for (int i = 0; i < 8; ++i) gvw[i] = *(const u32x4*)(GV + (R0 + ((i * 512 + tid) >> 5)) * D_MODEL + gq * 256 + c8);
            u32x2 guw[4][4];
#pragma unroll
            for (int j = 0; j < 4; ++j)
#pragma unroll
                for (int q4 = 0; q4 < 4; ++q4) guw[j][q4] = *(const u32x2*)(GU + (R0 + 32 * j + r32) * D_MODEL + gq * 256 + 32 * wave + 4 * hi5 + 8 * q4);
            const float* lg = AIN(I_LNVG) + gq * 256 + c8; const float* lb = AIN(I_LNVB) + gq * 256 + c8;
            const f32x4 g0 = *(const f32x4*)lg, g1 = *(const f32x4*)(lg + 4), b0 = *(const f32x4*)lb, b1 = *(const f32x4*)(lb + 4);
            if (gq != cur_g) {
                __syncthreads();
                const float* Wg = AIN(I_WS) + (size_t)gq * CHUNK * CHUNK;
#pragma unroll
                for (int i = 0; i < 8; ++i) { const int idx = i * 512 + tid, t = idx >> 5, s4 = (idx & 31) * 4; const f32x4 v = *(const f32x4*)(Wg + t * CHUNK + s4);
                    u32x2 w; w.x = cvt_pk_bf16(s4 + 0 <= t ? v[0] : 0.f, s4 + 1 <= t ? v[1] : 0.f); w.y = cvt_pk_bf16(s4 + 2 <= t ? v[2] : 0.f, s4 + 3 <= t ? v[3] : 0.f);
                    *(LAS u32x2*)(Wl + t * TST + s4 * 2) = w; }
                cur_g = gq;
            }
            { float sm = 0.f, sq = 0.f;
#pragma unroll
              for (int i = 0; i < 8; ++i) { sm += sp[i][0] + sp[i][2]; sq += sp[i][1] + sp[i][3]; }
              sm += swz_xor<1>(sm); sm += swz_xor<2>(sm); sq += swz_xor<1>(sq); sq += swz_xor<2>(sq);
              const float mean = sm * (1.f / D_MODEL), var = sq * (1.f / D_MODEL) - mean * mean;
              if ((tid & 3) == 0) stl[tid >> 2] = (f32x2){mean, rsqrtf(var + LN_EPS)}; }
            __syncthreads();
#pragma unroll
            for (int i = 0; i < 8; ++i) { const int sr = (i * 512 + tid) >> 5; f32x4 v0, v1; pg8::unpack8(gvw[i], v0, v1); const f32x2 st = stl[sr];
                v0 = (v0 - st.x) * st.y * g0 + b0; v1 = (v1 - st.x) * st.y * g1 + b1;
                const int sk = sr & 63, kk = (sk & ~0xC) | ((sk & 4) << 1) | ((sk & 8) >> 1), cc = c8 & 127;
                *(LAS u32x4*)(Tl + ((sr >> 6) * 2 + (c8 >> 7)) * 16384 + ((kk >> 3) * 4 + (cc >> 5)) * 512 + ((kk & 7) * 32 + (cc & 31)) * 2) = pg8::pack8(v0, v1); }
            __syncthreads();
            f32x16 acc[4];
#pragma unroll
            for (int j = 0; j < 4; ++j) acc[j] = (f32x16){0.f, 0.f, 0.f, 0.f, 0.f, 0.f, 0.f, 0.f, 0.f, 0.f, 0.f, 0.f, 0.f, 0.f, 0.f, 0.f};
#pragma unroll
            for (int ks = 0; ks < 8; ++ks) {
                s16x4 tl_, th_;
                switch (ks) {
                    case 0: tl_ = att::tr_read<0>(tvb); th_ = att::tr_read<2048>(tvb); break;
                    case 1: tl_ = att::tr_read<4096>(tvb); th_ = att::tr_read<6144>(tvb); break;
                    case 2: tl_ = att::tr_read<8192>(tvb); th_ = att::tr_read<10240>(tvb); break;
                    case 3: tl_ = att::tr_read<12288>(tvb); th_ = att::tr_read<14336>(tvb); break;
                    case 4: tl_ = att::tr_read<32768>(tvb); th_ = att::tr_read<34816>(tvb); break;
                    case 5: tl_ = att::tr_read<36864>(tvb); th_ = att::tr_read<38912>(tvb); break;
                    case 6: tl_ = att::tr_read<40960>(tvb); th_ = att::tr_read<43008>(tvb); break;
                    default: tl_ = att::tr_read<45056>(tvb); th_ = att::tr_read<47104>(tvb); break;
                }
                asm volatile("s_waitcnt lgkmcnt(0)" ::: "memory"); __builtin_amdgcn_sched_barrier(0);
                const bf16x8 a = (bf16x8){tl_[0], tl_[1], tl_[2], tl_[3], th_[0], th_[1], th_[2], th_[3]};
#pragma unroll
                for (int j = 0; j < 4; ++j) if (16 * ks <= 32 * j + 31) { const bf16x8 bw = *(const LAS bf16x8*)(Wl + (32 * j + r32) * TST + (16 * ks + 8 * hi5) * 2);
                    acc[j] = __builtin_amdgcn_mfma_f32_32x32x16_bf16(a, bw, acc[j], 0, 0, 0); } }
            const float* bsg = AIN(I_BS) + gq * CHUNK;
#pragma unroll
            for (int j = 0; j < 4; ++j) { const int t = 32 * j + r32; const float bsv = bsg[t]; bf16_t* yp = YO + (R0 + t) * D_MODEL + gq * 256 + 32 * wave + 4 * hi5;
#pragma unroll
                for (int q4 = 0; q4 < 4; ++q4) { const u32x2 w = guw[j][q4]; const f32x2 ga = pg8::gelu_pk((f32x2){bflo(w.x), bfhi(w.x)}), gb = pg8::gelu_pk((f32x2){bflo(w.y), bfhi(w.y)});
                    u32x2 o; o.x = cvt_pk_bf16(ga.x * (acc[j][4 * q4 + 0] + bsv), ga.y * (acc[j][4 * q4 + 1] + bsv)); o.y = cvt_pk_bf16(gb.x * (acc[j][4 * q4 + 2] + bsv), gb.y * (acc[j][4 * q4 + 3] + bsv));
                    *(u32x2*)(yp + 8 * q4) = o; } }
        }
        __syncthreads();
    }
    if (IN(3)) {
        LANE_HERE();
        float lam;
        { const float a = wave_sum(AIN(I_LQ1)[lane] * AIN(I_LK1)[lane] + AIN(I_LQ1)[lane + 64] * AIN(I_LK1)[lane + 64]);
          const float c = wave_sum(AIN(I_LQ2)[lane] * AIN(I_LK2)[lane] + AIN(I_LQ2)[lane + 64] * AIN(I_LK2)[lane + 64]);
          lam = sgpr_f(__expf(a) - __expf(c) + LAM_INIT); }
        const bf16_t* Qp = (const bf16_t*)(ws + WS_Q); const bf16_t* Kp = (const bf16_t*)(ws + WS_K); const bf16_t* Vp = (const bf16_t*)(ws + WS_V);
        LAS int* qslot = (LAS int*)(lds + ATT_Q_OFF);
        const unsigned myx = xb_xcc_id() & 7u;
#pragma unroll 1
        for (int rep = 0; rep < NREP(3); ++rep) {
        int li = 0;
#pragma unroll 1
        for (;;) {
            if (wave == 0 && lane_id() == 0) { int item = -1;
                while (li < 8) { const unsigned x = (myx + (unsigned)li) & 7u; const unsigned idx = __hip_atomic_fetch_add(ctl + CW_ATTQ + rep * 512 + 64 * x, 1u, __ATOMIC_RELAXED, __HIP_MEMORY_SCOPE_AGENT);
                    if (idx < (unsigned)(ATT_OFF[x + 1] - ATT_OFF[x])) { item = ATT_ITEMS[ATT_OFF[x] + idx]; break; } ++li; }
                *qslot = item; }
            ATT_BAR();
            const int item = __builtin_amdgcn_readfirstlane(*qslot);
            if (item < 0) break;
            int l2 = lane_id(); asm volatile("" : "+v"(l2));
            if (item >= 2048) { __builtin_amdgcn_s_waitcnt(0); ATT_BAR(); conv_chunk(item - 2048, ws, (LAS float*)(lds + RING_OFF + wave * 16384), wave, l2); continue; }
            const int b = item >> 10, h = (item >> 6) & 15, qbk = item & 63;
            const float slope2 = sgpr_f(exp2f(-0.5f * (float)(h + 1)) * 1.4426950408889634f);
#ifdef ATT_PROBE_VAR
            if (NREP(3) == 2 && rep == 0) att::attn_unit<ATT_PROBE_VAR>(lds + RING_OFF, (LAS float*)(lds + ATT_SCR_OFF), Qp, Kp, Vp, (bf16_t*)(ws + WS_H), b, h, qbk, lam, slope2, AIN(I_SUBLN), ctl + CW_KN, wave, lane);
            else
#endif
            att::attn_unit<0>(lds + RING_OFF, (LAS float*)(lds + ATT_SCR_OFF), Qp, Kp, Vp, (bf16_t*)(ws + ((NREP(3) == 2 && rep == 0) ? WS_H : WS_Q)), b, h, qbk, lam, slope2, AIN(I_SUBLN), ctl + CW_KN, wave, l2);
        }
        }
        if (BOTH(3)) xcd_barrier(bar, wave);
    }
    if (IN(4)) {
        { pg8::Gemm g{(const bf16_t*)(ws + WS_GU), WA, (const bf16_t*)(ws + WS_Q), WB, M_TOK, D_MODEL, 2 * D_MODEL, D_MODEL, D_MODEL / 64}; pg8::PanelOrder<2> S; S.init(M_TOK, G, bx);
          pg8::EpiMerge E{(const bf16_t*)(ws + WS_SA), (const unsigned char*)(ws + WS_SB), (bf16_t*)(ws + WS_MERGED)};
#if PROBE_NULLEPI & 1
          { pg8::EpiNull EN; pg8::gemm_phase<pg8::EpiNull, pg8::PanelOrder<2>, true, true>(lds + RING_OFF, g, S, EN, wave); }
#endif
#pragma unroll 1
          for (int rep = 0; rep < NREP(4); ++rep)
          pg8::gemm_phase<pg8::EpiMerge, pg8::PanelOrder<2>, true, true>(lds + RING_OFF, g, S, E, wave); }
        if (BOTH(4)) xcd_barrier(bar, wave);
    }
    if (IN(5)) {
        pg8::Gemm g{(const bf16_t*)(ws + WS_MERGED), WO, (const bf16_t*)(ws + WS_MERGED), WO, M_TOK, D_MODEL, D_MODEL, D_MODEL, D_MODEL / 64}; pg8::StaticOrder S; S.init(M_TOK, D_MODEL, G, bx);
        pg8::EpiResF32 E{AIN(I_X), HB, STAT1};
#if PROBE_NULLEPI & 2
        { pg8::EpiNull EN; pg8::gemm_phase<pg8::EpiNull, pg8::StaticOrder, true, true>(lds + RING_OFF, g, S, EN, wave); }
#endif
#pragma unroll 1
        for (int rep = 0; rep < NREP(5); ++rep)
        pg8::gemm_phase<pg8::EpiResF32, pg8::StaticOrder, true, true>(lds + RING_OFF, g, S, E, wave);
        if (BOTH(5)) xcd_barrier(bar, wave);
    }
    if (IN(6)) {
        pg8::Gemm g{HB, WGU, HB, WGU, M_TOK, 2 * D_FF, D_MODEL, D_MODEL, D_MODEL / 64}; pg8::StaticOrder S; S.init(M_TOK, 2 * D_FF, G, bx);
        pg8::Unit u0; const bool any = S.next(0, u0); { LANE_HERE(); if (any) fill_row_scale((LAS float*)(lds + RS_OFF), STAT1, u0.pm, wave, lane); }
        pg8::EpiSwiglu E{pg8::RowScale{(const LAS float*)(lds + RS_OFF), any ? u0.pm : -1, STAT1}, (bf16_t*)(ws + WS_HID)};
#pragma unroll 1
        for (int rep = 0; rep < NREP(6); ++rep)
        pg8::gemm_phase<pg8::EpiSwiglu, pg8::StaticOrder, true, true>(lds + RING_OFF, g, S, E, wave);
        { const int nwg6 = (M_TOK / 256) * (2 * D_FF / 256), rem = nwg6 % G, nw = rem ? G - rem : G, me = rem ? bx - rem : bx;
          if (me >= 0) { pg8::Gemm g2{PB, WPP, PB, WPP, M_TOK, D_MODEL, PLE_DIM, PLE_DIM, PLE_DIM / 64}; pg8::StaticOrder S2; S2.init(M_TOK, D_MODEL, nw, me);
            pg8::EpiPlain E2{(bf16_t*)(ws + WS_PP), D_MODEL};
#pragma unroll 1
            for (int rep = 0; rep < NREP(10); ++rep)
            pg8::gemm_phase<pg8::EpiPlain, pg8::StaticOrder, true, true>(lds + RING_OFF, g2, S2, E2, wave); } }
        if (BOTH(6)) xcd_barrier(bar, wave);
    }
    if (IN(7)) {
        pg8::Gemm g{(const bf16_t*)(ws + WS_HID), WDOWN, (const bf16_t*)(ws + WS_HID), WDOWN, M_TOK, D_MODEL, D_FF, D_FF, D_FF / 64}; pg8::PanelOrder<2> S; S.init(M_TOK, G, bx);
#pragma unroll 1
        for (int rep = 0; rep < NREP(7); ++rep) {
        pg8::EpiResBf E{HB, STAT2, (NREP(7) == 2 && rep == 0) ? (bf16_t*)(ws + WS_X3) : HB, ws + WS_X8};
        pg8::gemm_phase<pg8::EpiResBf, pg8::PanelOrder<2>, true, true>(lds + RING_OFF, g, S, E, wave); }
        if (BOTH(7)) xcd_barrier(bar, wave);
    }
    if (IN(8)) {
        const bf16_t* A8 = (const bf16_t*)(ws + WS_X8);
        pg8::Gemm g{A8, WPG, A8, WPG, M_TOK, D_MODEL, D_MODEL / 2, D_MODEL / 2, D_MODEL / 128}; pg8::StaticOrder S; S.init(M_TOK, D_MODEL, G, bx);
        pg8::Unit u0; const bool any = S.next(0, u0); { LANE_HERE(); if (any) fill_row_scale((LAS float*)(lds + RS_OFF), STAT2, u0.pm, wave, lane); }
        pg8::EpiPle E{pg8::RowScale{(const LAS float*)(lds + RS_OFF), any ? u0.pm : -1, STAT2}, HB, (const bf16_t*)(ws + WS_PP), (bf16_t*)(ws + WS_X3), STAT3};
#pragma unroll 1
        for (int rep = 0; rep < NREP(8); ++rep)
        pg8::gemm_phase<pg8::EpiPle, pg8::StaticOrder, true, true, true>(lds + RING_OFF, g, S, E, wave);
        if (BOTH(8)) xcd_barrier(bar, wave);
    }
    if (IN(9)) {
        LANE_HERE();
        const int gw = vcu * NWAVES + wave, NGW = G * NWAVES; const float* gf = AIN(I_GFINAL);
        const unsigned tmo = __hip_atomic_load(ctl + CW_BAR + XB_TMO, __ATOMIC_RELAXED, __HIP_MEMORY_SCOPE_AGENT);
        for (int m = gw; m < M_TOK; m += NGW) {
            float s = STAT3[(size_t)m * 64 + lane]; s = wave_sum(s);
            float rstd = rsqrtf(s * (1.f / D_MODEL) + RMS_EPS); if (tmo) rstd = __builtin_nanf("");
            GAS f32x4* xr = (GAS f32x4*)(args.out + (size_t)m * D_MODEL) + lane; const GAS u32x2* x3 = (const GAS u32x2*)((const bf16_t*)(ws + WS_X3) + (size_t)m * D_MODEL) + lane;
#pragma unroll
            for (int j = 0; j < 16; ++j) { const u32x2 w = x3[64 * j]; const f32x4 v = (f32x4){bflo(w.x), bfhi(w.x), bflo(w.y), bfhi(w.y)}; const f32x4 gv = *((const GAS f32x4*)gf + lane + 64 * j); xr[64 * j] = v * rstd * gv; }
        }
    }
#undef IN
#undef BOTH
}

extern "C" void kernel_launch(void* const* d_in, const int* in_sizes, int n_in, void* d_out, int out_size, void* d_ws, size_t ws_size, hipStream_t stream) {
    static int grid = 0;
    if (grid == 0) {
        if (n_in != 24 || out_size != M_TOK * D_MODEL || ws_size < WS_END) { fprintf(stderr, "kernel_launch: unexpected shapes (n_in %d, out %d, ws %zu < %zu)\n", n_in, out_size, ws_size, (size_t)WS_END); grid = -1; return; }
        int dev = 0, cus = 0, per_cu = 0;
        if (hipGetDevice(&dev) != hipSuccess || hipDeviceGetAttribute(&cus, hipDeviceAttributeMultiprocessorCount, dev) != hipSuccess) { grid = -1; return; }
        if (hipFuncSetAttribute((const void*)mk_fwd, hipFuncAttributeMaxDynamicSharedMemorySize, LDS_BYTES) != hipSuccess) { fprintf(stderr, "kernel_launch: hipFuncSetAttribute failed\n"); grid = -1; return; }
        if (hipOccupancyMaxActiveBlocksPerMultiprocessor(&per_cu, (const void*)mk_fwd, NWAVES * 64, LDS_BYTES) != hipSuccess || per_cu < 1) { fprintf(stderr, "kernel_launch: occupancy query says %d\n", per_cu); }
        (void)hipGetLastError();
        grid = cus;
    }
    if (grid < 0) return;
    (void)hipMemsetAsync((char*)d_ws + WS_CTL, 0, CTL_ZERO_BYTES, stream);
    Args a{};
    for (int i = 0; i < 24; ++i) a.in[i] = (const float*)d_in[i];
    a.out = (float*)d_out; a.ws = (unsigned char*)d_ws;
#if DBG_CHECK
    for (int k = 0; k < N_PHASES; ++k) { a.ph_lo = k; a.ph_hi = k + 1; hipLaunchKernelGGL(mk_fwd, dim3(grid), dim3(NWAVES * 64), LDS_BYTES, stream, a); }
#else
    a.ph_lo = 0; a.ph_hi = N_PHASES;
    hipLaunchKernelGGL(mk_fwd, dim3(grid), dim3(NWAVES * 64), LDS_BYTES, stream, a);
#endif
}
```

```cpp
#include <hip/hip_runtime.h>
#include <cstdio>
#include <cstdint>

#ifndef PROBE_NULLEPI
#define PROBE_NULLEPI 0
#endif
#ifndef DBG_CHECK
#define DBG_CHECK 0
#endif

#define LAS __attribute__((address_space(3)))
#define GAS __attribute__((address_space(1)))
typedef unsigned short bf16_t;
typedef short bf16x8 __attribute__((ext_vector_type(8)));
typedef short s16x4 __attribute__((ext_vector_type(4)));
typedef float f32x4 __attribute__((ext_vector_type(4)));
typedef float f32x2 __attribute__((ext_vector_type(2)));
typedef float f32x16 __attribute__((ext_vector_type(16)));
typedef unsigned u32x4 __attribute__((ext_vector_type(4)));
typedef unsigned u32x2 __attribute__((ext_vector_type(2)));
typedef int i32x4 __attribute__((ext_vector_type(4)));
typedef int i32x8 __attribute__((ext_vector_type(8)));

constexpr int D_MODEL = 4096, BATCH = 2, SEQ = 8192, M_TOK = BATCH * SEQ;
constexpr int PLE_DIM = 256, HEAD_DIM = 128, N_HEADS = 16, V_HEAD_DIM = 256;
constexpr int D_FF = 11008, IN_TOTAL = 28672, CHUNK = 128, GROUPS = 16;
constexpr float RMS_EPS = 1e-6f, LN_EPS = 1e-5f, LAM_INIT = 0.2f;
constexpr float QSCALE = 0.08838834764831845f * 1.4426950408889634f;

typedef __bf16 bf16x2_t __attribute__((ext_vector_type(2)));
__device__ __forceinline__ unsigned cvt_pk_bf16(float lo, float hi) { const f32x2 v = {lo, hi}; const bf16x2_t r = __builtin_convertvector(v, bf16x2_t); return __builtin_bit_cast(unsigned, r); }
__device__ __forceinline__ unsigned pk_fp8x4(float a, float b, float c, float d) {
    a = __builtin_amdgcn_fmed3f(a, -448.f, 448.f); b = __builtin_amdgcn_fmed3f(b, -448.f, 448.f); c = __builtin_amdgcn_fmed3f(c, -448.f, 448.f); d = __builtin_amdgcn_fmed3f(d, -448.f, 448.f);
    int w = __builtin_amdgcn_cvt_pk_fp8_f32(a, b, 0, false); w = __builtin_amdgcn_cvt_pk_fp8_f32(c, d, w, true); return (unsigned)w; }
constexpr float F8_SA = 16.f, F8_SW = 1024.f, F8_DESC = 1.f / (16.f * 1024.f);
__device__ __forceinline__ float bf2f(unsigned short b) { return __uint_as_float(((unsigned)b) << 16); }
__device__ __forceinline__ float bflo(unsigned w) { return __uint_as_float(w << 16); }
__device__ __forceinline__ float bfhi(unsigned w) { return __uint_as_float(w & 0xffff0000u); }
template <int K> __device__ __forceinline__ float swz_xor(float v) { return __int_as_float(__builtin_amdgcn_ds_swizzle(__float_as_int(v), (K << 10) | 0x1f)); }
__device__ __forceinline__ float half_sum(float v) { v += swz_xor<1>(v); v += swz_xor<2>(v); v += swz_xor<4>(v); v += swz_xor<8>(v); v += swz_xor<16>(v); return v; }
__device__ __forceinline__ float wave_sum(float v) { v = half_sum(v); auto rr = __builtin_amdgcn_permlane32_swap(__float_as_uint(v), __float_as_uint(v), false, false); return __uint_as_float(rr[0]) + __uint_as_float(rr[1]); }
__device__ __forceinline__ float sgpr_f(float v) { return __uint_as_float(__builtin_amdgcn_readfirstlane(__float_as_uint(v))); }
__device__ __forceinline__ int lane_id() { int l; asm volatile("v_mbcnt_lo_u32_b32 %0, -1, 0\n\tv_mbcnt_hi_u32_b32 %0, -1, %0" : "=v"(l)); return l; }
__device__ __forceinline__ float sigm(float x) { return __builtin_amdgcn_rcpf(1.f + __builtin_amdgcn_exp2f(-1.4426950408889634f * x)); }

namespace pg8 {
constexpr int BM = 256, BK = 64, HALF = 128, HTB = HALF * BK * 2, STAGE_BYTES = 8 * HTB, NXCD = 8, WGM = 8;
__host__ __device__ __forceinline__ int lds_byte(int r, int c) { const int st = (r >> 4) * 2 + (c >> 5), rr = r & 15, cc = c & 31, ob = rr * 64 + cc * 2; return st * 1024 + (ob ^ (((ob >> 9) & 1) << 5)); }
__host__ __device__ __forceinline__ void stage_rc(int b, int& R, int& C) { const int st = b / 1024, sb = b % 1024, swz = sb ^ (((sb >> 9) & 1) << 5); R = (st >> 1) * 16 + swz / 64; C = (st & 1) * 32 + (swz % 64) / 2; }
__host__ __device__ __forceinline__ int perm32(int rho) { const int n = rho >> 4, i = rho & 15; return 8 * (i >> 2) + 4 * n + (i & 3); }

struct Unit { int pm, pn; };
struct Gemm { const bf16_t* A; const bf16_t* Bt; const bf16_t* A2; const bf16_t* Bt2; int M, N, K, ld, nt1; };

struct StaticOrder {
    int nM, nN, nwg, G, c;
    __host__ __device__ void init(int M, int N, int G_, int c_) { nM = M / BM; nN = N / BM; nwg = nM * nN; G = G_; c = c_; }
    __host__ __device__ bool next(int i, Unit& u) const {
        const long L = (long)i * G + c; if (L >= nwg) return false;
        int wgid = (int)L; { const int q = nwg / NXCD, r = nwg % NXCD, xcd = wgid % NXCD, off = wgid / NXCD; wgid = (xcd < r ? xcd * (q + 1) : r * (q + 1) + (xcd - r) * q) + off; }
        const int nig = WGM * nN, gid = wgid / nig, fm = gid * WGM, gsz = (nM - fm) < WGM ? (nM - fm) : WGM;
        u.pm = fm + ((wgid % nig) % gsz); u.pn = (wgid % nig) / gsz; return true;
    }
};

template <int PA> struct PanelOrder {
    int nM, G, c, NX;
    __host__ __device__ void init(int M, int G_, int c_) { nM = M / BM; G = G_; c = c_; NX = (G % NXCD == 0 && nM % NXCD == 0) ? NXCD : 1; }
    __host__ __device__ bool next(int i, Unit& u) const {
        const int per = G / NX, x = c % NX, r = c / NX, ppx = nM / NX;
        const int idx = i * per + r;
        const int blk = idx / (PA * 16), w = idx % (PA * 16), pl = blk * PA + w / 16;
        if (pl >= ppx) return false;
        u.pm = x * ppx + pl; u.pn = w % 16; return true;
    }
};
__device__ __forceinline__ f32x2 gelu_pk(f32x2 v) {
    const f32x2 av = __builtin_elementwise_abs(v), d = av * 0.2316418882f + 1.0f;
    f32x2 t; t.x = __builtin_amdgcn_rcpf(d.x); t.y = __builtin_amdgcn_rcpf(d.y);
    f32x2 q = t * 0.5307027145f + (-0.7265760135f); q = q * t + 0.7107068705f; q = q * t + (-0.142248368f); q = q * t + 0.127414796f; q = q * t;
    const f32x2 s = (v * v) * (-0.72134752044f);
    f32x2 e; e.x = __builtin_amdgcn_exp2f(s.x); e.y = __builtin_amdgcn_exp2f(s.y);
    const f32x2 m = v * (q * e), r = v - m;
    f32x2 o; o.x = v.x < 0.f ? m.x : r.x; o.y = v.y < 0.f ? m.y : r.y; return o;
}
__device__ __forceinline__ f32x4 gelu4(f32x4 v) { const f32x2 a = gelu_pk((f32x2){v[0], v[1]}), b = gelu_pk((f32x2){v[2], v[3]}); return (f32x4){a.x, a.y, b.x, b.y}; }
__device__ __forceinline__ f32x4 sigm4(f32x4 v) { return (f32x4){sigm(v[0]), sigm(v[1]), sigm(v[2]), sigm(v[3])}; }
__device__ __forceinline__ u32x4 pack8(f32x4 v0, f32x4 v1) { u32x4 w; w.x = cvt_pk_bf16(v0[0], v0[1]); w.y = cvt_pk_bf16(v0[2], v0[3]); w.z = cvt_pk_bf16(v1[0], v1[1]); w.w = cvt_pk_bf16(v1[2], v1[3]); return w; }
__device__ __forceinline__ void unpack8(u32x4 w, f32x4& v0, f32x4& v1) { v0 = (f32x4){bflo(w.x), bfhi(w.x), bflo(w.y), bfhi(w.y)}; v1 = (f32x4){bflo(w.z), bfhi(w.z), bflo(w.w), bfhi(w.w)}; }
__device__ __forceinline__ float hsum4(f32x4 v) { return (v[0] + v[1]) + (v[2] + v[3]); }
__device__ __forceinline__ float hsq4(f32x4 v) { return (v[0] * v[0] + v[1] * v[1]) + (v[2] * v[2] + v[3] * v[3]); }
__device__ __forceinline__ float row_rstd(const float* stat, int row, int fq, float eps) {
    const f32x4* p = (const f32x4*)(stat + (size_t)row * 64 + fq * 16);
    const f32x4 a = p[0], b = p[1], c = p[2], d = p[3];
    float s = (hsum4(a) + hsum4(b)) + (hsum4(c) + hsum4(d));
    s += __shfl_xor(s, 16); s += __shfl_xor(s, 32);
    return rsqrtf(s * (1.0f / D_MODEL) + eps);
}

struct EpiProj {
    static constexpr bool PERM = true, HAS_MID = false;
    bf16_t* O; float* statv; unsigned* kn;
    __device__ __forceinline__ void mid(f32x4 (&)[2][2][4][2], const Unit&, int, int, int, int) const {}
    __device__ __forceinline__ void operator()(const f32x4 (&acc)[2][2][4][2], const Unit& u, int wr, int wc, int fr, int fq) const {
        const int t = u.pn >> 4, ct = u.pn & 15;
        const int row0 = u.pm * BM + wr * 64 + fr, col0 = ct * BM + wc * 32 + 8 * fq;
        bf16_t* base = O + (size_t)t * ((size_t)M_TOK * D_MODEL);
        if (t == 1) {
#pragma unroll
            for (int ai = 0; ai < 2; ++ai)
#pragma unroll
                for (int m = 0; m < 4; ++m) { const int row = row0 + ai * HALF + m * 16; bf16_t* rowp = base + (size_t)row * D_MODEL + col0; float s = 0.f, ss = 0.f;
#pragma unroll
                    for (int bj = 0; bj < 2; ++bj) { const f32x4 v0 = gelu4(acc[ai][bj][m][0]), v1 = gelu4(acc[ai][bj][m][1]);
                        s += hsum4(v0) + hsum4(v1); ss += hsq4(v0) + hsq4(v1);
                        *(u32x4*)(rowp + bj * HALF) = pack8(v0, v1); }
                    s += __shfl_xor(s, 16); s += __shfl_xor(s, 32); ss += __shfl_xor(ss, 16); ss += __shfl_xor(ss, 32);
                    if (fq == 0) *(f32x2*)(statv + ((size_t)row * 64 + ct * 4 + wc) * 2) = (f32x2){s, ss}; }
        } else {
            const float sc = (t == 2) ? QSCALE : 1.f;
            if (t == 3) {
                float mx0 = 0.f, mx1 = 0.f;
#pragma unroll
                for (int ai = 0; ai < 2; ++ai)
#pragma unroll
                    for (int m = 0; m < 4; ++m) { float s0 = hsq4(acc[ai][0][m][0]) + hsq4(acc[ai][0][m][1]), s1 = hsq4(acc[ai][1][m][0]) + hsq4(acc[ai][1][m][1]);
                        s0 += __shfl_xor(s0, 16); s0 += __shfl_xor(s0, 32); s1 += __shfl_xor(s1, 16); s1 += __shfl_xor(s1, 32); mx0 = fmaxf(mx0, s0); mx1 = fmaxf(mx1, s1); }
                mx0 = fmaxf(mx0, swz_xor<1>(mx0)); mx0 = fmaxf(mx0, swz_xor<2>(mx0)); mx0 = fmaxf(mx0, swz_xor<4>(mx0)); mx0 = fmaxf(mx0, swz_xor<8>(mx0));
                mx1 = fmaxf(mx1, swz_xor<1>(mx1)); mx1 = fmaxf(mx1, swz_xor<2>(mx1)); mx1 = fmaxf(mx1, swz_xor<4>(mx1)); mx1 = fmaxf(mx1, swz_xor<8>(mx1));
                if (fr == 0 && fq == 0) { unsigned* kp = kn + (((u.pm >> 5) * 16 + ct) * 2) * 4 + wc; atomicMax(kp, __float_as_uint(mx0)); atomicMax(kp + 4, __float_as_uint(mx1)); }
            }
#pragma unroll
            for (int ai = 0; ai < 2; ++ai)
#pragma unroll
                for (int m = 0; m < 4; ++m) { bf16_t* rowp = base + (size_t)(row0 + ai * HALF + m * 16) * D_MODEL + col0;
#pragma unroll
                    for (int bj = 0; bj < 2; ++bj) *(u32x4*)(rowp + bj * HALF) = pack8(acc[ai][bj][m][0] * sc, acc[ai][bj][m][1] * sc); }
        }
    }
};
struct EpiGates {
    static constexpr bool PERM = true, HAS_MID = false;
    bf16_t* O; const float* bgate;
    __device__ __forceinline__ void mid(f32x4 (&)[2][2][4][2], const Unit&, int, int, int, int) const {}
    __device__ __forceinline__ void operator()(const f32x4 (&acc)[2][2][4][2], const Unit& u, int wr, int wc, int fr, int fq) const {
        const int row0 = u.pm * BM + wr * 64 + fr, col0 = u.pn * HALF + wc * 32 + 8 * fq;
        bf16_t* RA = O + (size_t)5 * ((size_t)M_TOK * D_MODEL); bf16_t* SBo = O + (size_t)6 * ((size_t)M_TOK * D_MODEL);
        const f32x4 a0 = *(const f32x4*)(bgate + col0), a1 = *(const f32x4*)(bgate + col0 + 4), b0 = *(const f32x4*)(bgate + D_MODEL + col0), b1 = *(const f32x4*)(bgate + D_MODEL + col0 + 4);
#pragma unroll
        for (int ai = 0; ai < 2; ++ai)
#pragma unroll
            for (int m = 0; m < 4; ++m) { const size_t off = (size_t)(row0 + ai * HALF + m * 16) * D_MODEL + col0;
                f32x4 r0, r1, s0, s1;
#pragma unroll
                for (int j = 0; j < 4; ++j) {
                    const float ea0 = 1.f + __builtin_amdgcn_exp2f(-1.4426950408889634f * (acc[ai][0][m][0][j] * F8_DESC + a0[j])), ea1 = 1.f + __builtin_amdgcn_exp2f(-1.4426950408889634f * (acc[ai][0][m][1][j] * F8_DESC + a1[j]));
                    const float eb0 = 1.f + __builtin_amdgcn_exp2f(-1.4426950408889634f * (acc[ai][1][m][0][j] * F8_DESC + b0[j])), eb1 = 1.f + __builtin_amdgcn_exp2f(-1.4426950408889634f * (acc[ai][1][m][1][j] * F8_DESC + b1[j]));
                    r0[j] = eb0 * __builtin_amdgcn_rcpf(ea0); r1[j] = eb1 * __builtin_amdgcn_rcpf(ea1); s0[j] = __builtin_amdgcn_rcpf(eb0); s1[j] = __builtin_amdgcn_rcpf(eb1); }
                *(u32x4*)(RA + off) = pack8(r0, r1); *(u32x4*)(SBo + off) = pack8(s0, s1); }
    }
};
template <int MODE> struct EpiProbe {
    static constexpr bool PERM = true, HAS_MID = false;
    bf16_t* O;
    __device__ __forceinline__ void mid(f32x4 (&)[2][2][4][2], const Unit&, int, int, int, int) const {}
    __device__ __forceinline__ void operator()(const f32x4 (&acc)[2][2][4][2], const Unit& u, int wr, int wc, int fr, int fq) const {
        const int t = u.pn >> 4, ct = u.pn & 15;
        const int row0 = u.pm * BM + wr * 64 + fr, col0 = ct * BM + wc * 32 + 8 * fq;
        bf16_t* base = O + (size_t)t * ((size_t)M_TOK * D_MODEL);
#pragma unroll
        for (int ai = 0; ai < 2; ++ai)
#pragma unroll
            for (int m = 0; m < 4; ++m) { bf16_t* rowp = base + (size_t)(row0 + ai * HALF + m * 16) * D_MODEL + col0;
#pragma unroll
                for (int bj = 0; bj < 2; ++bj) { if (MODE == 1) *(u32x4*)(rowp + bj * HALF) = pack8(acc[ai][bj][m][0], acc[ai][bj][m][1]);
                    else asm volatile("" :: "v"(acc[ai][bj][m][0]), "v"(acc[ai][bj][m][1])); } }
    }
};
struct EpiNull {
    static constexpr bool PERM = true, HAS_MID = false;
    __device__ __forceinline__ void mid(f32x4 (&)[2][2][4][2], const Unit&, int, int, int, int) const {}
    __device__ __forceinline__ void operator()(const f32x4 (&acc)[2][2][4][2], const Unit&, int, int, int, int) const {
#pragma unroll
        for (int ai = 0; ai < 2; ++ai)
#pragma unroll
            for (int m = 0; m < 4; ++m)
#pragma unroll
                for (int bj = 0; bj < 2; ++bj) asm volatile("" :: "v"(acc[ai][bj][m][0]), "v"(acc[ai][bj][m][1]));
    }
};
struct EpiPlain {
    static constexpr bool PERM = true, HAS_MID = false;
    bf16_t* O; int ldc;
    __device__ __forceinline__ void mid(f32x4 (&)[2][2][4][2], const Unit&, int, int, int, int) const {}
    __device__ __forceinline__ void operator()(const f32x4 (&acc)[2][2][4][2], const Unit& u, int wr, int wc, int fr, int fq) const {
        const int row0 = u.pm * BM + wr * 64 + fr, col0 = u.pn * BM + wc * 32 + 8 * fq;
#pragma unroll
        for (int ai = 0; ai < 2; ++ai)
#pragma unroll
            for (int m = 0; m < 4; ++m) { bf16_t* rowp = O + (size_t)(row0 + ai * HALF + m * 16) * ldc + col0;
#pragma unroll
                for (int bj = 0; bj < 2; ++bj) *(u32x4*)(rowp + bj * HALF) = pack8(acc[ai][bj][m][0], acc[ai][bj][m][1]); }
    }
};
struct EpiMerge {
    static constexpr bool PERM = true, HAS_MID = true;
    const bf16_t* RA; const bf16_t* SB; bf16_t* O;
    __device__ __forceinline__ void mid(f32x4 (&acc)[2][2][4][2], const Unit& u, int wr, int wc, int fr, int fq) const {
        const int row0 = u.pm * BM + wr * 64 + fr, col0 = u.pn * BM + wc * 32 + 8 * fq;
        u32x4 w[2][4][2];
#pragma unroll
        for (int ai = 0; ai < 2; ++ai)
#pragma unroll
            for (int m = 0; m < 4; ++m)
#pragma unroll
                for (int bj = 0; bj < 2; ++bj) w[ai][m][bj] = *(const u32x4*)(RA + (size_t)(row0 + ai * HALF + m * 16) * D_MODEL + col0 + bj * HALF);
#pragma unroll
        for (int ai = 0; ai < 2; ++ai)
#pragma unroll
            for (int m = 0; m < 4; ++m)
#pragma unroll
                for (int bj = 0; bj < 2; ++bj) { f32x4 a0, a1; unpack8(w[ai][m][bj], a0, a1); acc[ai][bj][m][0] *= a0; acc[ai][bj][m][1] *= a1; }
        asm volatile("" ::: "memory");
    }
    __device__ __forceinline__ void operator()(const f32x4 (&acc)[2][2][4][2], const Unit& u, int wr, int wc, int fr, int fq) const {
        const int row0 = u.pm * BM + wr * 64 + fr, col0 = u.pn * BM + wc * 32 + 8 * fq;
        u32x4 w[2][4][2];
#pragma unroll
        for (int ai = 0; ai < 2; ++ai)
#pragma unroll
            for (int m = 0; m < 4; ++m)
#pragma unroll
                for (int bj = 0; bj < 2; ++bj) w[ai][m][bj] = *(const u32x4*)(SB + (size_t)(row0 + ai * HALF + m * 16) * D_MODEL + col0 + bj * HALF);
#pragma unroll
        for (int ai = 0; ai < 2; ++ai) {
#pragma unroll
            for (int m = 0; m < 4; ++m)
#pragma unroll
                for (int bj = 0; bj < 2; ++bj) { f32x4 b0, b1; unpack8(w[ai][m][bj], b0, b1);
                    *(u32x4*)(O + (size_t)(row0 + ai * HALF + m * 16) * D_MODEL + col0 + bj * HALF) = pack8(acc[ai][bj][m][0] * b0, acc[ai][bj][m][1] * b1); }
            asm volatile("" ::: "memory"); }
    }
};
struct EpiResF32 {
    static constexpr bool PERM = true, HAS_MID = false;
    const float* res; bf16_t* XB; float* stat;
    __device__ __forceinline__ void mid(f32x4 (&)[2][2][4][2], const Unit&, int, int, int, int) const {}
    __device__ __forceinline__ void operator()(const f32x4 (&acc)[2][2][4][2], const Unit& u, int wr, int wc, int fr, int fq) const {
        const int row0 = u.pm * BM + wr * 64 + fr, col0 = u.pn * BM + wc * 32 + 8 * fq;
#pragma unroll
        for (int ai = 0; ai < 2; ++ai) { f32x4 r[4][2][2];
#pragma unroll
            for (int m = 0; m < 4; ++m)
#pragma unroll
                for (int bj = 0; bj < 2; ++bj) { const float* p = res + (size_t)(row0 + ai * HALF + m * 16) * D_MODEL + col0 + bj * HALF; r[m][bj][0] = *(const f32x4*)p; r[m][bj][1] = *(const f32x4*)(p + 4); }
#pragma unroll
            for (int m = 0; m < 4; ++m) { const int row = row0 + ai * HALF + m * 16; const size_t off = (size_t)row * D_MODEL + col0; float ss = 0.f;
#pragma unroll
                for (int bj = 0; bj < 2; ++bj) { const f32x4 v0 = r[m][bj][0] + acc[ai][bj][m][0], v1 = r[m][bj][1] + acc[ai][bj][m][1];
                    ss += hsq4(v0) + hsq4(v1); *(u32x4*)(XB + off + bj * HALF) = pack8(v0, v1); }
                ss += __shfl_xor(ss, 16); ss += __shfl_xor(ss, 32);
                if (fq == 0) stat[(size_t)row * 64 + u.pn * 4 + wc] = ss; }
            asm volatile("" ::: "memory"); }
    }
};
struct EpiResBf {
    static constexpr bool PERM = true, HAS_MID = false;
    bf16_t* XB; float* stat; bf16_t* XO; unsigned char* X8;
    __device__ __forceinline__ void mid(f32x4 (&)[2][2][4][2], const Unit&, int, int, int, int) const {}
    __device__ __forceinline__ void operator()(const f32x4 (&acc)[2][2][4][2], const Unit& u, int wr, int wc, int fr, int fq) const {
        const int row0 = u.pm * BM + wr * 64 + fr, col0 = u.pn * BM + wc * 32 + 8 * fq;
        u32x4 w[2][4][2];
#pragma unroll
        for (int ai = 0; ai < 2; ++ai)
#pragma unroll
            for (int m = 0; m < 4; ++m)
#pragma unroll
                for (int bj = 0; bj < 2; ++bj) w[ai][m][bj] = *(const u32x4*)(XB + (size_t)(row0 + ai * HALF + m * 16) * D_MODEL + col0 + bj * HALF);
#pragma unroll
        for (int ai = 0; ai < 2; ++ai) {
#pragma unroll
            for (int m = 0; m < 4; ++m) { const int row = row0 + ai * HALF + m * 16; const size_t off = (size_t)row * D_MODEL + col0; float ss = 0.f;
#pragma unroll
                for (int bj = 0; bj < 2; ++bj) { f32x4 r0, r1; unpack8(w[ai][m][bj], r0, r1); const f32x4 v0 = r0 + acc[ai][bj][m][0], v1 = r1 + acc[ai][bj][m][1];
                    ss += hsq4(v0) + hsq4(v1); *(u32x4*)(XO + off + bj * HALF) = pack8(v0, v1);
                    const f32x4 s0 = v0 * F8_SA, s1 = v1 * F8_SA; *(u32x2*)(X8 + off + bj * HALF) = (u32x2){pk_fp8x4(s0[0], s0[1], s0[2], s0[3]), pk_fp8x4(s1[0], s1[1], s1[2], s1[3])}; }
                ss += __shfl_xor(ss, 16); ss += __shfl_xor(ss, 32);
                if (fq == 0) stat[(size_t)row * 64 + u.pn * 4 + wc] = ss; }
            asm volatile("" ::: "memory"); }
    }
};
struct RowScale { const LAS float* rs_lds; int rs_pm; const float* stat;
    __device__ __forceinline__ float get(const Unit& u, int rt, int row, int fq) const { return (u.pm == rs_pm) ? rs_lds[rt] : row_rstd(stat, row, fq, RMS_EPS); } };
struct EpiSwiglu {
    static constexpr bool PERM = true, HAS_MID = false;
    RowScale rsc; bf16_t* O;
    __device__ __forceinline__ void mid(f32x4 (&)[2][2][4][2], const Unit&, int, int, int, int) const {}
    __device__ __forceinline__ void operator()(const f32x4 (&acc)[2][2][4][2], const Unit& u, int wr, int wc, int fr, int fq) const {
        const int rt0 = wr * 64 + fr, row0 = u.pm * BM + rt0, col0 = u.pn * HALF + wc * 32 + 8 * fq;
#pragma unroll
        for (int ai = 0; ai < 2; ++ai)
#pragma unroll
            for (int m = 0; m < 4; ++m) { const int row = row0 + ai * HALF + m * 16; const float rs = rsc.get(u, rt0 + ai * HALF + m * 16, row, fq);
                f32x4 h0, h1;
#pragma unroll
                for (int j = 0; j < 4; ++j) { const float g0 = acc[ai][0][m][0][j] * rs, g1 = acc[ai][0][m][1][j] * rs;
                    h0[j] = g0 * sigm(g0) * (acc[ai][1][m][0][j] * rs); h1[j] = g1 * sigm(g1) * (acc[ai][1][m][1][j] * rs); }
                *(u32x4*)(O + (size_t)row * D_FF + col0) = pack8(h0, h1); }
    }
};
struct EpiPle {
    static constexpr bool PERM = true, HAS_MID = false;
    RowScale rsc; const bf16_t* XB2; const bf16_t* PP; bf16_t* X3; float* stat3;
    __device__ __forceinline__ void mid(f32x4 (&)[2][2][4][2], const Unit&, int, int, int, int) const {}
    __device__ __forceinline__ void operator()(const f32x4 (&acc)[2][2][4][2], const Unit& u, int wr, int wc, int fr, int fq) const {
        const int rt0 = wr * 64 + fr, row0 = u.pm * BM + rt0, col0 = u.pn * BM + wc * 32 + 8 * fq;
#pragma unroll
        for (int ai = 0; ai < 2; ++ai) { u32x4 wx[4][2], wp[4][2];
#pragma unroll
            for (int m = 0; m < 4; ++m)
#pragma unroll
                for (int bj = 0; bj < 2; ++bj) { const size_t off = (size_t)(row0 + ai * HALF + m * 16) * D_MODEL + col0 + bj * HALF; wx[m][bj] = *(const u32x4*)(XB2 + off); wp[m][bj] = *(const u32x4*)(PP + off); }
#pragma unroll
            for (int m = 0; m < 4; ++m) { const int row = row0 + ai * HALF + m * 16; const size_t off = (size_t)row * D_MODEL + col0; float ss = 0.f;
                const float rs = rsc.get(u, rt0 + ai * HALF + m * 16, row, fq) * F8_DESC;
#pragma unroll
                for (int bj = 0; bj < 2; ++bj) { f32x4 r0, r1, p0, p1; unpack8(wx[m][bj], r0, r1); unpack8(wp[m][bj], p0, p1);
                    const f32x4 v0 = r0 + sigm4(acc[ai][bj][m][0] * rs) * p0, v1 = r1 + sigm4(acc[ai][bj][m][1] * rs) * p1;
                    ss += hsq4(v0) + hsq4(v1); *(u32x4*)(X3 + off + bj * HALF) = pack8(v0, v1); }
                ss += __shfl_xor(ss, 16); ss += __shfl_xor(ss, 32);
                if (fq == 0) stat3[(size_t)row * 64 + u.pn * 4 + wc] = ss; }
            asm volatile("" ::: "memory"); }
    }
};

__device__ __forceinline__ i32x8 cat8(bf16x8 a, bf16x8 b) { const i32x4 x = __builtin_bit_cast(i32x4, a), y = __builtin_bit_cast(i32x4, b); return __builtin_shufflevector(x, y, 0, 1, 2, 3, 4, 5, 6, 7); }
__device__ __forceinline__ void mfma_f8(f32x4& acc, i32x8 a, i32x8 b) { asm volatile("v_mfma_f32_16x16x128_f8f6f4 %0, %1, %2, %0" : "+v"(acc) : "v"(a), "v"(b)); }
template <class Epi, class Sched, bool ALIGN_EPI, bool SP2, bool F8 = false>
__device__ __forceinline__ void gemm_phase(LAS unsigned char* lds, const Gemm g, const Sched& S, const Epi& E, const int wid) {
    int lane = lane_id(); asm volatile("" : "+v"(lane));
    const int tid = wid * 64 + lane, wr = wid >> 2, wc = wid & 3, fr = lane & 15, fq = lane >> 4;
    int nt = g.K / BK, nt1 = g.nt1; asm volatile("" : "+s"(nt), "+s"(nt1));
    const int ld = g.ld;
    unsigned voffA[2], voffB[2];
#pragma unroll
    for (int i = 0; i < 2; ++i) { int R, C; stage_rc(tid * 16 + i * 8192, R, C); const int Rb = Epi::PERM ? ((R & ~31) + perm32(R & 31)) : R;
        voffA[i] = (unsigned)(R * ld + C) * 2u; voffB[i] = (unsigned)(Rb * ld + C) * 2u; }
    const size_t kstep = (size_t)(BK * 2);
    const size_t hstep = (size_t)HALF * ld * 2;
    const size_t tstep = 2 * hstep;
    const size_t seg2 = (size_t)nt1 * kstep;
    const unsigned ldsw = (unsigned)wid * 1024u;
    const int aoff = lds_byte(wr * 64 + fr, fq * 8), boff = lds_byte(wc * 32 + fr, fq * 8);
#define PG8_SA(b, h) (((b) * 2 + (h)) * HTB)
#define PG8_SB(b, h) ((4 + (b) * 2 + (h)) * HTB)
#define PG8_STAGE(bufoff, gbase, voff) do { _Pragma("unroll") for (int _i = 0; _i < 2; ++_i) \
        __builtin_amdgcn_global_load_lds((const unsigned*)((const char*)(gbase) + (voff)[_i]), (LAS unsigned*)(lds + (bufoff) + ldsw + _i * 8192), 16, 0, 0); } while (0)
#define PG8_LDA(dst, b, h) do { _Pragma("unroll") for (int m = 0; m < 4; ++m) _Pragma("unroll") for (int k = 0; k < 2; ++k) dst[m][k] = *(const LAS bf16x8*)(lds + PG8_SA(b, h) + aoff + m * 2048 + k * 1024); } while (0)
#define PG8_LDB(dst, b, h) do { _Pragma("unroll") for (int n = 0; n < 2; ++n) _Pragma("unroll") for (int k = 0; k < 2; ++k) dst[n][k] = *(const LAS bf16x8*)(lds + PG8_SB(b, h) + boff + n * 2048 + k * 1024); } while (0)
#define PG8_MMA(ai, bj, At, Bt) do { __builtin_amdgcn_s_setprio(1); \
        if constexpr (F8) { _Pragma("unroll") for (int m = 0; m < 4; ++m) _Pragma("unroll") for (int n = 0; n < 2; ++n) \
            mfma_f8(acc[ai][bj][m][n], cat8(Bt[n][0], Bt[n][1]), cat8(At[m][0], At[m][1])); } \
        else { _Pragma("unroll") for (int m = 0; m < 4; ++m) _Pragma("unroll") for (int n = 0; n < 2; ++n) _Pragma("unroll") for (int k = 0; k < 2; ++k) \
            acc[ai][bj][m][n] = __builtin_amdgcn_mfma_f32_16x16x32_bf16(Bt[n][k], At[m][k], acc[ai][bj][m][n], 0, 0, 0); } \
        __builtin_amdgcn_s_setprio(0); } while (0)
#define PG8_WAIT_V(n) asm volatile("s_waitcnt vmcnt(" #n ")" ::: "memory")
#define PG8_WAIT_L(n) asm volatile("s_waitcnt lgkmcnt(" #n ")" ::: "memory")
#define PG8_BAR __builtin_amdgcn_s_barrier()
#define PG8_SCHED __builtin_amdgcn_sched_barrier(0)
    Unit cur, nxt; int ui = 0;
    if (!S.next(0, cur)) return;
    f32x4 acc[2][2][4][2];
#pragma unroll
    for (int a = 0; a < 2; ++a)
#pragma unroll
        for (int b = 0; b < 2; ++b)
#pragma unroll
            for (int m = 0; m < 4; ++m)
#pragma unroll
                for (int n = 0; n < 2; ++n) acc[a][b][m][n] = (f32x4){0.f, 0.f, 0.f, 0.f};
    bf16x8 At[4][2], B0[2][2], B1[2][2];
    const char* cA = (const char*)g.A + (size_t)cur.pm * tstep; const char* cB = (const char*)g.Bt + (size_t)cur.pn * tstep;
    const char* cA2 = (const char*)g.A2 + (size_t)cur.pm * tstep - seg2; const char* cB2 = (const char*)g.Bt2 + (size_t)cur.pn * tstep - seg2;
    if constexpr (SP2) {
        PG8_STAGE(PG8_SB(0, 0), cB, voffB); PG8_STAGE(PG8_SB(0, 1), cB + hstep, voffB); PG8_STAGE(PG8_SA(0, 0), cA, voffA); PG8_STAGE(PG8_SA(0, 1), cA + hstep, voffA);
        if (wr == 1) PG8_BAR;
        PG8_WAIT_V(2); PG8_BAR;
        PG8_STAGE(PG8_SB(1, 0), cB + kstep, voffB); PG8_STAGE(PG8_SA(1, 0), cA + kstep, voffA); PG8_STAGE(PG8_SB(1, 1), cB + hstep + kstep, voffB);
        PG8_WAIT_V(6); PG8_BAR;
    } else {
        PG8_STAGE(PG8_SB(0, 0), cB, voffB); PG8_STAGE(PG8_SA(0, 0), cA, voffA); PG8_STAGE(PG8_SB(0, 1), cB + hstep, voffB); PG8_STAGE(PG8_SA(0, 1), cA + hstep, voffA);
        if (wr == 1) PG8_BAR;
        PG8_WAIT_V(4); PG8_BAR;
        PG8_STAGE(PG8_SB(1, 0), cB + kstep, voffB); PG8_STAGE(PG8_SA(1, 0), cA + kstep, voffA); PG8_STAGE(PG8_SB(1, 1), cB + hstep + kstep, voffB);
        PG8_WAIT_V(6); PG8_BAR;
    }
    for (;;) {
        const bool has_next = S.next(ui + 1, nxt);
        const char* nA = has_next ? (const char*)g.A + (size_t)nxt.pm * tstep : cA; const char* nB = has_next ? (const char*)g.Bt + (size_t)nxt.pn * tstep : cB;
        for (int t = 0; t < nt; t += 2) {
            const bool last = (t == nt - 2);
            const char* a1 = ((t + 1 < nt1) ? cA : cA2) + (size_t)(t + 1) * kstep;
            const bool s1 = (t + 2 < nt1);
            const char* a2 = last ? nA : (s1 ? cA : cA2) + (size_t)(t + 2) * kstep; const char* b2 = last ? nB : (s1 ? cB : cB2) + (size_t)(t + 2) * kstep;
            const char* a3 = a2 + kstep; const char* b3 = b2 + kstep;
            if constexpr (Epi::HAS_MID) { if (t == nt1) { int l2 = lane; asm volatile("" : "+v"(l2)); E.mid(acc, cur, wr, wc, l2 & 15, l2 >> 4); } }
            if constexpr (SP2) {
            PG8_LDB(B0, 0, 0); PG8_LDB(B1, 0, 1); PG8_SCHED; PG8_LDA(At, 0, 0); PG8_STAGE(PG8_SA(1, 1), a1 + hstep, voffA);
            PG8_WAIT_V(8); PG8_WAIT_L(0); PG8_BAR; PG8_MMA(0, 0, At, B0); PG8_MMA(0, 1, At, B1); PG8_BAR; PG8_SCHED;
            PG8_LDA(At, 0, 1); PG8_STAGE(PG8_SB(0, 0), b2, voffB); PG8_STAGE(PG8_SB(0, 1), b2 + hstep, voffB); PG8_STAGE(PG8_SA(0, 0), a2, voffA);
            PG8_WAIT_V(8); PG8_WAIT_L(0); PG8_BAR; PG8_MMA(1, 0, At, B0); PG8_MMA(1, 1, At, B1); PG8_BAR; PG8_SCHED;
            PG8_LDB(B0, 1, 0); PG8_LDB(B1, 1, 1); PG8_SCHED; PG8_LDA(At, 1, 0); PG8_STAGE(PG8_SA(0, 1), a2 + hstep, voffA);
            PG8_WAIT_V(8); PG8_WAIT_L(0); PG8_BAR; PG8_MMA(0, 0, At, B0); PG8_MMA(0, 1, At, B1); PG8_BAR; PG8_SCHED;
            PG8_LDA(At, 1, 1); PG8_STAGE(PG8_SB(1, 0), b3, voffB); PG8_STAGE(PG8_SB(1, 1), b3 + hstep, voffB); PG8_STAGE(PG8_SA(1, 0), a3, voffA);
            PG8_WAIT_V(8); PG8_WAIT_L(0); PG8_BAR; PG8_MMA(1, 0, At, B0); PG8_MMA(1, 1, At, B1); PG8_BAR; PG8_SCHED;
            } else {
            PG8_LDB(B0, 0, 0); PG8_SCHED; PG8_LDA(At, 0, 0); PG8_STAGE(PG8_SA(1, 1), a1 + hstep, voffA);
            PG8_WAIT_L(8); PG8_BAR; PG8_WAIT_L(0); PG8_MMA(0, 0, At, B0); PG8_BAR; PG8_SCHED;
            PG8_LDB(B1, 0, 1); PG8_STAGE(PG8_SB(0, 0), b2, voffB);
            PG8_BAR; PG8_WAIT_L(0); PG8_MMA(0, 1, At, B1); PG8_BAR;
            PG8_LDA(At, 0, 1); PG8_STAGE(PG8_SA(0, 0), a2, voffA);
            PG8_BAR; PG8_WAIT_L(0); PG8_MMA(1, 0, At, B0); PG8_BAR; PG8_SCHED;
            PG8_STAGE(PG8_SB(0, 1), b2 + hstep, voffB);
            PG8_WAIT_V(6); PG8_BAR; PG8_MMA(1, 1, At, B1); PG8_BAR;
            PG8_LDB(B0, 1, 0); PG8_SCHED; PG8_LDA(At, 1, 0); PG8_STAGE(PG8_SA(0, 1), a2 + hstep, voffA);
            PG8_WAIT_L(8); PG8_BAR; PG8_WAIT_L(0); PG8_MMA(0, 0, At, B0); PG8_BAR; PG8_SCHED;
            PG8_LDB(B1, 1, 1); PG8_STAGE(PG8_SB(1, 0), b3, voffB);
            PG8_BAR; PG8_WAIT_L(0); PG8_MMA(0, 1, At, B1); PG8_BAR;
            PG8_LDA(At, 1, 1); PG8_STAGE(PG8_SA(1, 0), a3, voffA);
            PG8_BAR; PG8_WAIT_L(0); PG8_MMA(1, 0, At, B0); PG8_BAR; PG8_SCHED;
            PG8_STAGE(PG8_SB(1, 1), b3 + hstep, voffB);
            PG8_WAIT_V(6); PG8_BAR; PG8_MMA(1, 1, At, B1); PG8_BAR;
            }
        }
        if constexpr (ALIGN_EPI) { if (wr == 0) PG8_BAR; }
        if constexpr (F8) asm volatile("s_nop 15\n\ts_nop 15" ::: "memory");
        { int l2 = lane; asm volatile("" : "+v"(l2)); E(acc, cur, wr, wc, l2 & 15, l2 >> 4); }
        if (!has_next) break;
#pragma unroll
        for (int a = 0; a < 2; ++a)
#pragma unroll
            for (int b = 0; b < 2; ++b)
#pragma unroll
                for (int m = 0; m < 4; ++m)
#pragma unroll
                    for (int n = 0; n < 2; ++n) acc[a][b][m][n] = (f32x4){0.f, 0.f, 0.f, 0.f};
        cur = nxt; cA = nA; cB = nB; ++ui;
        cA2 = (const char*)g.A2 + (size_t)cur.pm * tstep - seg2; cB2 = (const char*)g.Bt2 + (size_t)cur.pn * tstep - seg2;
        if constexpr (ALIGN_EPI) { if (wr == 1) PG8_BAR; }
    }
    PG8_WAIT_V(0);
    if constexpr (!ALIGN_EPI) { if (wr == 0) PG8_BAR; }
    PG8_BAR;
#undef PG8_SA
#undef PG8_SB
#undef PG8_STAGE
#undef PG8_LDA
#undef PG8_LDB
#undef PG8_MMA
#undef PG8_WAIT_V
#undef PG8_WAIT_L
#undef PG8_BAR
#undef PG8_SCHED
}
}

namespace att {
constexpr int STG = 65536;
__device__ __forceinline__ const char* uni_ptr(const char* p) { const unsigned long long v = (unsigned long long)p; const unsigned lo = __builtin_amdgcn_readfirstlane((unsigned)v), hi = __builtin_amdgcn_readfirstlane((unsigned)(v >> 32)); return (const char*)(((unsigned long long)hi << 32) | lo); }
#define KSWZ(row, colB) ((row) * 256 + ((colB) ^ (((row) & 7) << 4)))
__device__ __forceinline__ int crow(int r, int hi) { return (r & 3) + 8 * (r >> 2) + 4 * hi; }
__device__ __forceinline__ int v_rd_base(int lane) { return ((lane & 3) << 3) | (((lane >> 2) & 3) << 6) | (((lane >> 4) & 1) << 5) | (((lane >> 5) & 1) << 8); }
constexpr int v_rd_off(int d0, int ks, int half) { return d0 * 512 + ks * 4096 + half * 2048; }
template <int OFF> __device__ __forceinline__ s16x4 tr_read(int vb) { s16x4 r; asm volatile("ds_read_b64_tr_b16 %0, %1 offset:%2" : "=&v"(r) : "v"(vb), "i"(OFF) : "memory"); return r; }
template <int D0> __device__ __forceinline__ void pv_one(f32x16& od, int vb, bf16x8 pa0, bf16x8 pa1, bf16x8 pa2, bf16x8 pa3) {
    const s16x4 l0 = tr_read<v_rd_off(D0, 0, 0)>(vb), h0 = tr_read<v_rd_off(D0, 0, 1)>(vb), l1 = tr_read<v_rd_off(D0, 1, 0)>(vb), h1 = tr_read<v_rd_off(D0, 1, 1)>(vb);
    const s16x4 l2 = tr_read<v_rd_off(D0, 2, 0)>(vb), h2 = tr_read<v_rd_off(D0, 2, 1)>(vb), l3 = tr_read<v_rd_off(D0, 3, 0)>(vb), h3 = tr_read<v_rd_off(D0, 3, 1)>(vb);
    asm volatile("s_waitcnt lgkmcnt(0)" ::: "memory"); __builtin_amdgcn_sched_barrier(0);
#define PK(L, H) (bf16x8){L[0], L[1], L[2], L[3], H[0], H[1], H[2], H[3]}
    od = __builtin_amdgcn_mfma_f32_32x32x16_bf16(pa0, PK(l0, h0), od, 0, 0, 0);
    od = __builtin_amdgcn_mfma_f32_32x32x16_bf16(pa1, PK(l1, h1), od, 0, 0, 0);
    od = __builtin_amdgcn_mfma_f32_32x32x16_bf16(pa2, PK(l2, h2), od, 0, 0, 0);
    od = __builtin_amdgcn_mfma_f32_32x32x16_bf16(pa3, PK(l3, h3), od, 0, 0, 0);
#undef PK
}
template <int D0> __device__ __forceinline__ void pv_ld(s16x4 (&t)[8], int vb) {
    constexpr int B = (D0 >> 2) * 16384, D = D0 & 3;
    t[0] = tr_read<B + v_rd_off(D, 0, 0)>(vb); t[1] = tr_read<B + v_rd_off(D, 0, 1)>(vb); t[2] = tr_read<B + v_rd_off(D, 1, 0)>(vb); t[3] = tr_read<B + v_rd_off(D, 1, 1)>(vb);
    t[4] = tr_read<B + v_rd_off(D, 2, 0)>(vb); t[5] = tr_read<B + v_rd_off(D, 2, 1)>(vb); t[6] = tr_read<B + v_rd_off(D, 3, 0)>(vb); t[7] = tr_read<B + v_rd_off(D, 3, 1)>(vb);
}
__device__ __forceinline__ void pv_mm(f32x16& od, const s16x4 (&t)[8], bf16x8 pa0, bf16x8 pa1, bf16x8 pa2, bf16x8 pa3) {
#define PK(L, H) (bf16x8){L[0], L[1], L[2], L[3], H[0], H[1], H[2], H[3]}
    od = __builtin_amdgcn_mfma_f32_32x32x16_bf16(pa0, PK(t[0], t[1]), od, 0, 0, 0);
    od = __builtin_amdgcn_mfma_f32_32x32x16_bf16(pa1, PK(t[2], t[3]), od, 0, 0, 0);
    od = __builtin_amdgcn_mfma_f32_32x32x16_bf16(pa2, PK(t[4], t[5]), od, 0, 0, 0);
    od = __builtin_amdgcn_mfma_f32_32x32x16_bf16(pa3, PK(t[6], t[7]), od, 0, 0, 0);
#undef PK
}
#define PV_WAIT(n) do { asm volatile("s_waitcnt lgkmcnt(" #n ")" ::: "memory"); __builtin_amdgcn_sched_barrier(0); } while (0)
__device__ __forceinline__ void pv_all(f32x16 (&o)[8], int vb, bf16x8 pa0, bf16x8 pa1, bf16x8 pa2, bf16x8 pa3) {
    s16x4 ta[8], tb[8];
    pv_ld<0>(ta, vb);
    pv_ld<1>(tb, vb); PV_WAIT(8); pv_mm(o[0], ta, pa0, pa1, pa2, pa3);
    pv_ld<2>(ta, vb); PV_WAIT(8); pv_mm(o[1], tb, pa0, pa1, pa2, pa3);
    pv_ld<3>(tb, vb); PV_WAIT(8); pv_mm(o[2], ta, pa0, pa1, pa2, pa3);
    pv_ld<4>(ta, vb); PV_WAIT(8); pv_mm(o[3], tb, pa0, pa1, pa2, pa3);
    pv_ld<5>(tb, vb); PV_WAIT(8); pv_mm(o[4], ta, pa0, pa1, pa2, pa3);
    pv_ld<6>(ta, vb); PV_WAIT(8); pv_mm(o[5], tb, pa0, pa1, pa2, pa3);
    pv_ld<7>(tb, vb); PV_WAIT(8); pv_mm(o[6], ta, pa0, pa1, pa2, pa3);
    PV_WAIT(0); pv_mm(o[7], tb, pa0, pa1, pa2, pa3);
}
#define ATT_BAR() do { asm volatile("s_waitcnt vmcnt(0) lgkmcnt(0)" ::: "memory"); __builtin_amdgcn_s_barrier(); asm volatile("" ::: "memory"); } while (0)

template <int VAR  >
__device__ __forceinline__ void attn_unit(LAS unsigned char* lds, LAS float* scr, const bf16_t* Qg, const bf16_t* Kg, const bf16_t* Vg, bf16_t* Og,
                                          int b, int h, int qb, float lam, float slope2, const float* subln_g, const unsigned* kn, int wid, int lane) {
    asm volatile("" : "+v"(lane));
    const int mp = wid >> 2, rq = wid & 3, r32 = lane & 31, hi = lane >> 5;
    const int q0 = qb * 128, NT = 2 * qb + 2;
    const size_t rowbase = (size_t)b * SEQ;
    unsigned koff[2], voff[2];
#pragma unroll
    for (int j = 0; j < 2; ++j) {
        const int blk = j * 8 + wid;
        { const int row = blk * 4 + (lane >> 4), chunk = (lane & 15) ^ (row & 7); koff[j] = (unsigned)(row * D_MODEL + chunk * 8) * 2u; }
        { const int sub = blk * 2 + (lane >> 5), kk = (sub >> 2) * 8 + ((lane & 31) >> 2), k = (kk & ~0xC) | ((kk & 4) << 1) | ((kk & 8) >> 1);
          voff[j] = (unsigned)(k * D_MODEL + (sub & 3) * 32 + (lane & 3) * 8) * 2u; }
    }
    const char* Kh = uni_ptr((const char*)(Kg + rowbase * D_MODEL + h * 256));
    const char* Vh = uni_ptr((const char*)(Vg + rowbase * D_MODEL + h * 256));
#define ATT_ISSUE(t, stg) do { const char* kt_ = Kh + (size_t)(t) * (64 * D_MODEL * 2); const char* vt_ = Vh + (size_t)(t) * (64 * D_MODEL * 2); LAS unsigned char* sb_ = lds + (stg) * STG + wid * 1024; \
        _Pragma("unroll") for (int i_ = 0; i_ < 8; ++i_) { const char* ub_ = (i_ < 4) ? kt_ + (i_ >> 1) * 256 : vt_ + ((i_ >> 1) & 1) * 256; const unsigned vo_ = (i_ < 4) ? koff[i_ & 1] : voff[i_ & 1]; \
            __builtin_amdgcn_global_load_lds((const unsigned*)(ub_ + vo_), (LAS unsigned*)(sb_ + i_ * 8192), 16, 0, 0); } } while (0)
    ATT_ISSUE(NT - 1, 0);
    bf16x8 qr[8];
    { const bf16_t* Qw = Qg + (rowbase + q0 + 32 * rq + r32) * D_MODEL + h * 256 + mp * 128 + hi * 8;
#pragma unroll
      for (int d0 = 0; d0 < 8; ++d0) qr[d0] = *(const bf16x8*)(Qw + d0 * 16); }
    int kb[16];
#pragma unroll
    for (int r = 0; r < 16; ++r) { const float kv = slope2 * (float)((r & 3) + 8 * (r >> 2)); asm volatile("s_nop 0\n\tv_readfirstlane_b32 %0, %1" : "=s"(kb[r]) : "v"(kv)); }
    const float off32 = 32.f * slope2;
    f32x16 o[8];
#pragma unroll
    for (int d = 0; d < 8; ++d) o[d] = (f32x16){0.f, 0.f, 0.f, 0.f, 0.f, 0.f, 0.f, 0.f, 0.f, 0.f, 0.f, 0.f, 0.f, 0.f, 0.f, 0.f};
    float m_run = -1e30f, l_run = 0.f;
    const int vb0 = (int)(uintptr_t)(lds) + 32768 + v_rd_base(lane);
    LAS float* al_l = scr + wid * 64;
    { float q2 = 0.f;
#pragma unroll
      for (int d0 = 0; d0 < 8; ++d0) { const u32x4 w = __builtin_bit_cast(u32x4, qr[d0]);
          q2 += bflo(w.x) * bflo(w.x) + bfhi(w.x) * bfhi(w.x) + bflo(w.y) * bflo(w.y) + bfhi(w.y) * bfhi(w.y) + bflo(w.z) * bflo(w.z) + bfhi(w.z) * bfhi(w.z) + bflo(w.w) * bflo(w.w) + bfhi(w.w) * bfhi(w.w); }
      { auto rr = __builtin_amdgcn_permlane32_swap(__float_as_uint(q2), __float_as_uint(q2), false, false); q2 = __uint_as_float(rr[0]) + __uint_as_float(rr[1]); }
      q2 = fmaxf(q2, swz_xor<1>(q2)); q2 = fmaxf(q2, swz_xor<2>(q2)); q2 = fmaxf(q2, swz_xor<4>(q2)); q2 = fmaxf(q2, swz_xor<8>(q2)); q2 = fmaxf(q2, swz_xor<16>(q2));
      if (lane == 0) al_l[40] = q2; }
    int jmax = NT;
    if (wid >= 4) __builtin_amdgcn_s_setprio(1);
    for (int j = 0; j < jmax; ++j) {
        const int t = NT - 1 - j, stg = j & 1;
        ATT_BAR();
        if (j == 0) {
            float q2m = 0.f;
#pragma unroll
            for (int w8 = 0; w8 < 8; ++w8) q2m = fmaxf(q2m, scr[w8 * 64 + 40]);
            const unsigned* kp = kn + ((b * 16 + h) * 2) * 4;
            const float k2 = 1.02f * fmaxf((__uint_as_float(kp[0]) + __uint_as_float(kp[1])) + (__uint_as_float(kp[2]) + __uint_as_float(kp[3])), (__uint_as_float(kp[4]) + __uint_as_float(kp[5])) + (__uint_as_float(kp[6]) + __uint_as_float(kp[7])));
            const float W = (158.f + 2.f * sqrtf(q2m * k2)) / slope2;
            const float xs = ((float)(q0 - 63) - W) * (1.f / 64.f);
            int ts = xs > 0.f ? (int)ceilf(xs) : 0; ts = ts < NT - 2 ? ts : NT - 2;
            jmax = NT - __builtin_amdgcn_readfirstlane(ts);
        }
        if (j + 1 < jmax) ATT_ISSUE(t - 1, stg ^ 1);
        const LAS unsigned char* Ks = lds + stg * STG + mp * 16384;
        f32x16 p0, p1;
#pragma unroll
        for (int r = 0; r < 16; ++r) { int sb = kb[r]; asm volatile("" : "+s"(sb)); p0[r] = __int_as_float(sb); p1[r] = __int_as_float(sb); }
#pragma unroll
        for (int d0 = 0; d0 < 8; ++d0) { const int cb = (d0 * 16 + hi * 8) * 2;
            const bf16x8 b0 = *(const LAS bf16x8*)(Ks + KSWZ(r32, cb)), b1 = *(const LAS bf16x8*)(Ks + KSWZ(32 + r32, cb));
            p0 = __builtin_amdgcn_mfma_f32_32x32x16_bf16(b0, qr[d0], p0, 0, 0, 0);
            p1 = __builtin_amdgcn_mfma_f32_32x32x16_bf16(b1, qr[d0], p1, 0, 0, 0);
            if ((d0 & 3) == 3) asm volatile("" ::: "memory"); }
        if (t >= NT - 2) {
            const int lim = q0 + 32 * rq + r32 - 64 * t - 4 * hi;
#pragma unroll
            for (int r = 0; r < 16; ++r) { const int cr = (r & 3) + 8 * (r >> 2); p0[r] = (cr > lim) ? -__builtin_inff() : p0[r]; p1[r] = (cr + 32 > lim) ? -__builtin_inff() : p1[r]; }
        }
        const float gt = slope2 * (float)(64 * (t - NT) + 4 * hi);
        float pmax = p0[0], pmax1 = p1[0];
#pragma unroll
        for (int r = 1; r < 16; ++r) { if (VAR < 2) { pmax = fmaxf(pmax, p0[r]); pmax1 = fmaxf(pmax1, p1[r]); } }
        pmax = fmaxf(pmax, pmax1 + off32) + gt;
        { auto rr = __builtin_amdgcn_permlane32_swap(__float_as_uint(pmax), __float_as_uint(pmax), false, false); pmax = fmaxf(__uint_as_float(rr[0]), __uint_as_float(rr[1])); }
        float alpha = 1.f;
        if (!__all(pmax - m_run <= 8.f)) { const float mn = fmaxf(m_run, pmax); alpha = __builtin_amdgcn_exp2f(m_run - mn); m_run = mn; }
        const float mm = m_run - gt, mm1 = mm - off32;
        float ps = 0.f;
#pragma unroll
        for (int r = 0; r < 16; ++r) { if (VAR == 0) { p0[r] = __builtin_amdgcn_exp2f(p0[r] - mm); p1[r] = __builtin_amdgcn_exp2f(p1[r] - mm1); ps += p0[r] + p1[r]; }
            else if (VAR == 1) { p0[r] = (p0[r] - mm) * 1e-3f; p1[r] = (p1[r] - mm1) * 1e-3f; ps += p0[r] + p1[r]; } }
        { auto rr = __builtin_amdgcn_permlane32_swap(__float_as_uint(ps), __float_as_uint(ps), false, false); ps = __uint_as_float(rr[0]) + __uint_as_float(rr[1]); }
        l_run = l_run * alpha + ps;
        bf16x8 pa0, pa1, pa2, pa3;
#define PK4(P, BASE, OUT) do { const unsigned a0 = cvt_pk_bf16(P[BASE + 0], P[BASE + 1]), a1 = cvt_pk_bf16(P[BASE + 2], P[BASE + 3]);   \
    const unsigned b0 = cvt_pk_bf16(P[BASE + 4], P[BASE + 5]), b1 = cvt_pk_bf16(P[BASE + 6], P[BASE + 7]);                              \
    auto r0 = __builtin_amdgcn_permlane32_swap(a0, b0, false, false); auto r1 = __builtin_amdgcn_permlane32_swap(a1, b1, false, false); \
    u32x4 w = {r0[0], r1[0], r0[1], r1[1]}; OUT = *reinterpret_cast<bf16x8*>(&w); } while (0)
        PK4(p0, 0, pa0); PK4(p0, 8, pa1); PK4(p1, 0, pa2); PK4(p1, 8, pa3);
#undef PK4
        if (__any(alpha < 1.f)) {
            if (hi == 0) al_l[r32] = alpha;
            asm volatile("s_waitcnt lgkmcnt(0)" ::: "memory");
#pragma unroll
            for (int r = 0; r < 16; ++r) { const float a = al_l[crow(r, hi)];
#pragma unroll
                for (int d = 0; d < 8; ++d) o[d][r] *= a; }
        }
        const int vb = vb0 + stg * STG;
        pv_all(o, vb, pa0, pa1, pa2, pa3);
    }
    __builtin_amdgcn_s_setprio(0);
    ATT_BAR();
    { int l2 = lane; asm volatile("" : "+v"(l2)); lane = l2; }
    const int r32e = lane & 31, hie = lane >> 5;
    if (hie == 0) al_l[r32e] = l_run;
    asm volatile("s_waitcnt lgkmcnt(0)" ::: "memory");
#pragma unroll
    for (int r = 0; r < 16; ++r) { float a = __builtin_amdgcn_rcpf(al_l[(r & 3) + 8 * (r >> 2) + 4 * hie]); if (mp == 1) a *= lam;
#pragma unroll
        for (int d = 0; d < 8; ++d) o[d][r] *= a; }
    LAS float* X = (LAS float*)(lds + rq * 32768) + lane;
    if (mp == 1) {
#pragma unroll
        for (int d = 0; d < 8; ++d) {
#pragma unroll
            for (int r = 0; r < 16; ++r) X[(d * 16 + r) * 64] = o[d][r];
            asm volatile("" ::: "memory"); }
    }
    ATT_BAR();
    if (mp == 0) {
        float ss[16];
#pragma unroll
        for (int r = 0; r < 16; ++r) ss[r] = 0.f;
#pragma unroll
        for (int d = 0; d < 8; ++d) {
#pragma unroll
            for (int r = 0; r < 16; ++r) { const float v = o[d][r] - X[(d * 16 + r) * 64]; X[(d * 16 + r) * 64] = v; ss[r] += v * v; if (r == 7) asm volatile("" ::: "memory"); }
            asm volatile("" ::: "memory"); }
#pragma unroll
        for (int r = 0; r < 16; ++r) { const float f = rsqrtf(half_sum(ss[r]) * (1.0f / V_HEAD_DIM) + LN_EPS) * (1.0f - LAM_INIT); if (r32e == 0) al_l[(r & 3) + 8 * (r >> 2) + 4 * hie] = f; }
        asm volatile("s_waitcnt lgkmcnt(0)" ::: "memory");
        const f32x4 g0 = *(const f32x4*)(subln_g + 8 * r32e), g1 = *(const f32x4*)(subln_g + 8 * r32e + 4);
        const LAS float* Xr = (const LAS float*)(lds + rq * 32768) + (r32e >> 2) * 1024 + (r32e & 3) * 8;
        bf16_t* Ow = Og + (rowbase + q0 + 32 * rq + hie) * D_MODEL + h * 256 + 8 * r32e;
#pragma unroll
        for (int j = 0; j < 16; ++j) { int q = 2 * j; asm volatile("" : "+v"(q)); q += hie;
            const int rr = (q & 3) + 4 * (q >> 3), hh = (q >> 2) & 1;
            const LAS float* xp = Xr + rr * 64 + hh * 32; const f32x4 v0 = *(const LAS f32x4*)xp, v1 = *(const LAS f32x4*)(xp + 4); const float f = al_l[q];
            *(u32x4*)(Ow + (size_t)(2 * j) * D_MODEL) = pg8::pack8(v0 * f * g0, v1 * f * g1); }
    }
    ATT_BAR();
#undef ATT_ISSUE
}
}

constexpr size_t MiB = 1u << 20;
constexpr size_t WS_CTL = 0, CTL_ZERO_BYTES = 65536;
constexpr size_t WS_STATV = 2 * MiB, WS_STAT1 = 10 * MiB, WS_STAT2 = 14 * MiB, WS_STAT3 = 18 * MiB, WS_DIAG = 22 * MiB, WS_PB = 24 * MiB;
constexpr size_t WS_WIN = 32 * MiB, WS_WGU = 256 * MiB, WS_WDOWN = 428 * MiB, WS_WA = 514 * MiB, WS_WB = 546 * MiB, WS_WO = 578 * MiB, WS_WPG = 610 * MiB, WS_WPP = 642 * MiB;
constexpr size_t WS_H = 648 * MiB;
constexpr size_t WS_ACT = 776 * MiB, ACT_STRIDE = 128 * MiB;
constexpr size_t WS_GU = WS_ACT, WS_GV = WS_ACT + ACT_STRIDE, WS_Q = WS_ACT + 2 * ACT_STRIDE, WS_K = WS_ACT + 3 * ACT_STRIDE, WS_V = WS_ACT + 4 * ACT_STRIDE, WS_SA = WS_ACT + 5 * ACT_STRIDE, WS_SB = WS_ACT + 6 * ACT_STRIDE;
constexpr size_t WS_X3 = WS_SA;
constexpr size_t WS_WIN8 = WS_WIN + (size_t)5 * D_MODEL * D_MODEL * 2;
constexpr size_t WS_H8 = WS_ACT + 7 * ACT_STRIDE;
constexpr size_t WS_X8 = WS_SB;
constexpr size_t WS_MERGED = WS_GV, WS_PP = WS_K, WS_HID = WS_ACT;
constexpr size_t WS_END = WS_H8 + 64 * MiB;
static_assert(WS_WPP + 2 * MiB <= WS_H && WS_H + 128 * MiB <= WS_ACT && (size_t)M_TOK * D_FF * 2 <= 3 * ACT_STRIDE, "d_ws map");
constexpr int CW_BAR = 4096;
constexpr int CW_ATTQ = 8192;
constexpr int CW_KN = 12288;
static_assert((CW_KN + 2 * 16 * 2 * 4) * 4 <= (int)CTL_ZERO_BYTES && (CW_ATTQ + 1024) <= CW_KN && (CW_BAR + 3456) <= CW_ATTQ, "control words inside the per-call memset");
__device__ const unsigned short ATT_ITEMS[3208] = {767,1983,2048,765,1981,2056,763,1979,2064,761,1977,2072,698,2080,700,702,2088,696,759,2096,1975,694,2104,757,2112,1973,692,2120,755,1971,2128,690,753,2136,1969,2144,688,751,2152,1967,686,2160,749,1965,2168,684,747,2176,1963,2184,682,745,2192,1961,680,2200,743,1959,2208,678,2216,741,1957,2224,676,739,2232,1955,674,2240,737,2248,1953,672,2256,735,1951,2264,670,733,2272,1949,2280,542,544,2288,546,548,2296,550,552,2304,554,556,2312,558,2320,560,562,2328,564,566,2336,568,570,2344,572,2352,574,540,2360,668,731,2368,1947,538,2376,666,2384,729,1945,2392,536,664,2400,727,1943,2408,534,2416,662,725,2424,1941,469,2432,471,473,2440,475,477,2448,479,2456,481,483,2464,485,487,2472,489,491,2480,493,2488,495,497,2496,499,501,2504,503,505,2512,507,2520,509,511,2528,532,660,2536,467,723,2544,1939,2552,530,658,2560,465,721,2568,1937,528,2576,656,463,2584,719,2592,1935,526,2600,654,461,2608,717,1933,2616,524,2624,652,459,2632,715,1931,2640,331,333,2648,335,2656,337,339,2664,341,343,2672,345,347,2680,349,351,2688,353,2696,355,357,2704,359,361,2712,363,365,2720,367,2728,369,371,2736,373,375,2744,377,379,2752,381,2760,383,522,2768,650,329,2776,457,713,2784,1929,2792,520,648,2800,327,455,2808,711,1927,2816,518,646,2824,325,2832,453,709,2840,1925,132,2848,134,136,2856,138,2864,140,142,2872,144,146,2880,148,150,2888,152,2896,154,156,2904,158,160,2912,162,164,2920,166,2928,168,170,2936,172,174,2944,176,178,2952,180,182,2960,184,2968,186,188,2976,190,516,2984,644,323,2992,451,3000,707,1923,3008,2,4,3016,6,8,3024,10,3032,12,14,3040,16,18,3048,20,22,3056,24,3064,26,28,3072,30,32,3080,34,36,3088,38,40,3096,42,3104,44,46,3112,48,50,3120,52,54,3128,56,3136,58,60,3144,62,130,3152,514,642,3160,321,3168,449,705,3176,1921,0,3184,128,512,3192,640,3200,831,2047,2049,829,2045,2057,827,2043,2065,825,2041,2073,1722,2081,1724,1726,2089,1720,823,2097,2039,1718,2105,821,2113,2037,1716,2121,819,2035,2129,1714,817,2137,2033,2145,1712,815,2153,2031,1710,2161,813,2029,2169,1708,811,2177,2027,2185,1706,809,2193,2025,1704,2201,807,2023,2209,1702,2217,805,2021,2225,1700,803,2233,2019,1698,2241,801,2249,2017,1696,2257,799,2015,2265,1694,797,2273,2013,2281,1566,1568,2289,1570,1572,2297,1574,1576,2305,1578,1580,2313,1582,2321,1584,1586,2329,1588,1590,2337,1592,1594,2345,1596,2353,1598,1564,2361,1692,795,2369,2011,1562,2377,1690,2385,793,2009,2393,1560,1688,2401,791,2007,2409,1558,2417,1686,789,2425,2005,1493,2433,1495,1497,2441,1499,1501,2449,1503,2457,1505,1507,2465,1509,1511,2473,1513,1515,2481,1517,2489,1519,1521,2497,1523,1525,2505,1527,1529,2513,1531,2521,1533,1535,2529,1556,1684,2537,787,1491,2545,2003,2553,1554,1682,2561,785,1489,2569,2001,1552,2577,1680,783,2585,1487,2593,1999,1550,2601,1678,781,2609,1485,1997,2617,1548,2625,1676,779,2633,1483,1995,2641,1355,1357,2649,1359,2657,1361,1363,2665,1365,1367,2673,1369,1371,2681,1373,1375,2689,1377,2697,1379,1381,2705,1383,1385,2713,1387,1389,2721,1391,2729,1393,1395,2737,1397,1399,2745,1401,1403,2753,1405,2761,1407,1546,2769,1674,777,2777,1353,1481,2785,1993,2793,1544,1672,2801,775,1351,2809,1479,1991,2817,1542,1670,2825,773,2833,1349,1477,2841,1989,1156,2849,1158,1160,2857,1162,2865,1164,1166,2873,1168,1170,2881,1172,1174,2889,1176,2897,1178,1180,2905,1182,1184,2913,1186,1188,2921,1190,2929,1192,1194,2937,1196,1198,2945,1200,1202,2953,1204,1206,2961,1208,2969,1210,1212,2977,1214,1540,2985,1668,771,2993,1347,3001,1475,1987,3009,1026,1028,3017,1030,1032,3025,1034,3033,1036,1038,3041,1040,1042,3049,1044,1046,3057,1048,3065,1050,1052,3073,1054,1056,3081,1058,1060,3089,1062,1064,3097,1066,3105,1068,1070,3113,1072,1074,3121,1076,1078,3129,1080,3137,1082,1084,3145,1086,1154,3153,1538,1666,3161,769,3169,1345,1473,3177,1985,1024,3185,1152,1536,3193,1664,3201,895,1982,2050,893,1980,2058,891,1978,2066,889,697,2074,699,2082,701,703,2090,1976,695,2098,887,1974,2106,693,2114,885,1972,2122,691,883,2130,1970,689,2138,881,2146,1968,687,2154,879,1966,2162,685,877,2170,1964,683,2178,875,2186,1962,681,2194,873,1960,2202,679,871,2210,1958,2218,677,869,2226,1956,675,2234,867,1954,2242,673,2250,865,1952,2258,671,863,2266,1950,669,2274,861,2282,541,543,2290,545,547,2298,549,551,2306,553,555,2314,557,2322,559,561,2330,563,565,2338,567,569,2346,571,2354,573,575,2362,1948,539,2370,667,859,2378,1946,2386,537,665,2394,857,1944,2402,535,663,2410,855,2418,1942,533,2426,661,853,2434,468,470,2442,472,474,2450,476,2458,478,480,2466,482,484,2474,486,488,2482,490,2490,492,494,2498,496,498,2506,500,502,2514,504,2522,506,508,2530,510,1940,2538,531,659,2546,851,2554,466,1938,2562,529,657,2570,849,464,2578,1936,527,2586,655,2594,847,462,2602,1934,525,2610,653,845,2618,460,2626,1932,523,2634,651,843,2642,330,332,2650,334,2658,336,338,2666,340,342,2674,344,346,2682,348,350,2690,352,2698,354,356,2706,358,360,2714,362,364,2722,366,2730,368,370,2738,372,374,2746,376,378,2754,380,2762,382,458,2770,1930,521,2778,649,841,2786,328,2794,456,1928,2802,519,647,2810,839,326,2818,454,1926,2826,517,2834,645,837,2842,133,135,2850,137,139,2858,141,2866,143,145,2874,147,149,2882,151,153,2890,155,2898,157,159,2906,161,163,2914,165,167,2922,169,2930,171,173,2938,175,177,2946,179,181,2954,183,185,2962,187,2970,189,191,2978,324,452,2986,1924,131,2994,515,3002,643,835,3010,3,5,3018,7,9,3026,11,3034,13,15,3042,17,19,3050,21,23,3058,25,3066,27,29,3074,31,33,3082,35,37,3090,39,41,3098,43,3106,45,47,3114,49,51,3122,53,55,3130,57,3138,59,61,3146,63,322,3154,450,1922,3162,1,3170,129,513,3178,641,833,3186,320,448,3194,1920,3202,959,2046,2051,957,2044,2059,955,2042,2067,953,1721,2075,1723,2083,1725,1727,2091,2040,951,2099,1719,2038,2107,949,2115,1717,2036,2123,947,1715,2131,2034,945,2139,1713,2147,2032,943,2155,1711,2030,2163,941,1709,2171,2028,939,2179,1707,2187,2026,937,2195,1705,2024,2203,935,1703,2211,2022,2219,933,1701,2227,2020,931,2235,1699,2018,2243,929,2251,1697,2016,2259,927,1695,2267,2014,925,2275,1693,2283,1565,1567,2291,1569,1571,2299,1573,1575,2307,1577,1579,2315,1581,2323,1583,1585,2331,1587,1589,2339,1591,1593,2347,1595,2355,1597,1599,2363,2012,923,2371,1563,1691,2379,2010,2387,921,1561,2395,1689,2008,2403,919,1559,2411,1687,2419,2006,917,2427,1557,1685,2435,1492,1494,2443,1496,1498,2451,1500,2459,1502,1504,2467,1506,1508,2475,1510,1512,2483,1514,2491,1516,1518,2499,1520,1522,2507,1524,1526,2515,1528,2523,1530,1532,2531,1534,2004,2539,915,1555,2547,1683,2555,1490,2002,2563,913,1553,2571,1681,1488,2579,2000,911,2587,1551,2595,1679,1486,2603,1998,909,2611,1549,1677,2619,1484,2627,1996,907,2635,1547,1675,2643,1354,1356,2651,1358,2659,1360,1362,2667,1364,1366,2675,1368,1370,2683,1372,1374,2691,1376,2699,1378,1380,2707,1382,1384,2715,1386,1388,2723,1390,2731,1392,1394,2739,1396,1398,2747,1400,1402,2755,1404,2763,1406,1482,2771,1994,905,2779,1545,1673,2787,1352,2795,1480,1992,2803,903,1543,2811,1671,1350,2819,1478,1990,2827,901,2835,1541,1669,2843,1157,1159,2851,1161,1163,2859,1165,2867,1167,1169,2875,1171,1173,2883,1175,1177,2891,1179,2899,1181,1183,2907,1185,1187,2915,1189,1191,2923,1193,2931,1195,1197,2939,1199,1201,2947,1203,1205,2955,1207,1209,2963,1211,2971,1213,1215,2979,1348,1476,2987,1988,899,2995,1155,3003,1539,1667,3011,1027,1029,3019,1031,1033,3027,1035,3035,1037,1039,3043,1041,1043,3051,1045,1047,3059,1049,3067,1051,1053,3075,1055,1057,3083,1059,1061,3091,1063,1065,3099,1067,3107,1069,1071,3115,1073,1075,3123,1077,1079,3131,1081,3139,1083,1085,3147,1087,1346,3155,1474,1986,3163,897,3171,1025,1153,3179,1537,1665,3187,1344,1472,3195,1984,3203,1023,766,2052,1022,1021,2060,764,1020,2068,1019,762,2076,1018,2084,1017,760,2092,1016,1015,2100,758,1014,2108,1013,2116,756,1012,2124,1011,754,2132,1010,1009,2140,752,2148,1008,1007,2156,750,1006,2164,1005,748,2172,1004,1003,2180,746,2188,1002,1001,2196,617,619,2204,621,623,2212,625,2220,627,629,2228,631,633,2236,635,637,2244,639,2252,744,1000,2260,615,999,2268,742,998,2276,613,2284,997,740,2292,996,611,2300,995,738,2308,994,609,2316,993,2324,736,992,2332,607,991,2340,734,990,2348,605,2356,989,732,2364,988,603,2372,987,730,2380,986,2388,601,985,2396,728,984,2404,599,983,2412,726,2420,982,597,2428,981,724,2436,980,595,2444,979,722,2452,978,2460,593,977,2468,720,976,2476,591,975,2484,400,2492,402,404,2500,406,408,2508,410,412,2516,414,2524,416,418,2532,420,422,2540,424,426,2548,428,2556,430,432,2564,434,436,2572,438,440,2580,442,444,2588,446,2596,398,718,2604,974,589,2612,973,396,2620,716,2628,972,587,2636,971,394,2644,714,970,2652,585,2660,969,392,2668,712,968,2676,264,266,2684,268,270,2692,272,2700,274,276,2708,278,280,2716,282,284,2724,286,2732,288,290,2740,292,294,2748,296,298,2756,300,2764,302,304,2772,306,308,2780,310,312,2788,314,2796,316,318,2804,583,967,2812,262,390,2820,710,966,2828,198,2836,200,202,2844,204,206,2852,208,210,2860,212,2868,214,216,2876,218,220,2884,222,224,2892,226,2900,228,230,2908,232,234,2916,236,238,2924,240,2932,242,244,2940,246,248,2948,250,252,2956,254,581,2964,965,2972,196,260,2980,388,708,2988,964,579,2996,963,3004,68,70,3012,72,74,3020,76,78,3028,80,3036,82,84,3044,86,88,3052,90,92,3060,94,3068,96,98,3076,100,102,3084,104,106,3092,108,110,3100,112,3108,114,116,3116,118,120,3124,122,124,3132,126,3140,66,194,3148,258,386,3156,706,962,3164,577,3172,961,64,3180,192,256,3188,384,704,3196,960,3204,1791,830,2053,1790,1789,2061,828,1788,2069,1787,826,2077,1786,2085,1785,824,2093,1784,1783,2101,822,1782,2109,1781,2117,820,1780,2125,1779,818,2133,1778,1777,2141,816,2149,1776,1775,2157,814,1774,2165,1773,812,2173,1772,1771,2181,810,2189,1770,1769,2197,808,1641,2205,1643,1645,2213,1647,2221,1649,1651,2229,1653,1655,2237,1657,1659,2245,1661,2253,1663,1768,2261,1639,1767,2269,806,1766,2277,1637,2285,1765,804,2293,1764,1635,2301,1763,802,2309,1762,1633,2317,1761,2325,800,1760,2333,1631,1759,2341,798,1758,2349,1629,2357,1757,796,2365,1756,1627,2373,1755,794,2381,1754,2389,1625,1753,2397,792,1752,2405,1623,1751,2413,790,2421,1750,1621,2429,1749,788,2437,1748,1619,2445,1747,786,2453,1746,2461,1617,1745,2469,784,1744,2477,1615,1743,2485,1424,2493,1426,1428,2501,1430,1432,2509,1434,1436,2517,1438,2525,1440,1442,2533,1444,1446,2541,1448,1450,2549,1452,2557,1454,1456,2565,1458,1460,2573,1462,1464,2581,1466,1468,2589,1470,2597,782,1422,2605,1742,1613,2613,1741,780,2621,1420,2629,1740,1611,2637,1739,778,2645,1418,1738,2653,1609,2661,1737,776,2669,1416,1736,2677,1288,1290,2685,1292,1294,2693,1296,2701,1298,1300,2709,1302,1304,2717,1306,1308,2725,1310,2733,1312,1314,2741,1316,1318,2749,1320,1322,2757,1324,2765,1326,1328,2773,1330,1332,2781,1334,1336,2789,1338,2797,1340,1342,2805,1607,1735,2813,774,1286,2821,1414,1734,2829,1222,2837,1224,1226,2845,1228,1230,2853,1232,1234,2861,1236,2869,1238,1240,2877,1242,1244,2885,1246,1248,2893,1250,2901,1252,1254,2909,1256,1258,2917,1260,1262,2925,1264,2933,1266,1268,2941,1270,1272,2949,1274,1276,2957,1278,1605,2965,1733,2973,772,1220,2981,1284,1412,2989,1732,1603,2997,1731,3005,1092,1094,3013,1096,1098,3021,1100,1102,3029,1104,3037,1106,1108,3045,1110,1112,3053,1114,1116,3061,1118,3069,1120,1122,3077,1124,1126,3085,1128,1130,3093,1132,1134,3101,1136,3109,1138,1140,3117,1142,1144,3125,1146,1148,3133,1150,3141,770,1090,3149,1218,1282,3157,1410,1730,3165,1601,3173,1729,768,3181,1088,1216,3189,1280,1408,3197,1728,3205,1855,894,2054,1854,1853,2062,892,1852,2070,1851,890,2078,1850,2086,1849,888,2094,1848,1847,2102,886,1846,2110,1845,2118,884,1844,2126,1843,882,2134,1842,1841,2142,880,2150,1840,1839,2158,878,1838,2166,1837,876,2174,1836,1835,2182,874,2190,1834,1833,2198,616,618,2206,620,622,2214,624,2222,626,628,2230,630,632,2238,634,636,2246,638,2254,872,1832,2262,1831,614,2270,870,1830,2278,1829,2286,612,868,2294,1828,1827,2302,610,866,2310,1826,1825,2318,608,2326,864,1824,2334,1823,606,2342,862,1822,2350,1821,2358,604,860,2366,1820,1819,2374,602,858,2382,1818,2390,1817,600,2398,856,1816,2406,1815,598,2414,854,2422,1814,1813,2430,596,852,2438,1812,1811,2446,594,850,2454,1810,2462,1809,592,2470,848,1808,2478,1807,399,2486,401,2494,403,405,2502,407,409,2510,411,413,2518,415,2526,417,419,2534,421,423,2542,425,427,2550,429,2558,431,433,2566,435,437,2574,439,441,2582,443,445,2590,447,2598,590,846,2606,1806,397,2614,1805,588,2622,844,2630,1804,395,2638,1803,586,2646,842,1802,2654,393,2662,1801,584,2670,840,1800,2678,265,267,2686,269,271,2694,273,2702,275,277,2710,279,281,2718,283,285,2726,287,2734,289,291,2742,293,295,2750,297,299,2758,301,2766,303,305,2774,307,309,2782,311,313,2790,315,2798,317,319,2806,263,391,2814,1799,582,2822,838,1798,2830,197,2838,199,201,2846,203,205,2854,207,209,2862,211,2870,213,215,2878,217,219,2886,221,223,2894,225,2902,227,229,2910,231,233,2918,235,237,2926,239,2934,241,243,2942,245,247,2950,249,251,2958,253,255,2966,261,2974,389,1797,2982,580,836,2990,1796,195,2998,259,3006,387,1795,3014,67,69,3022,71,73,3030,75,3038,77,79,3046,81,83,3054,85,87,3062,89,3070,91,93,3078,95,97,3086,99,101,3094,103,105,3102,107,3110,109,111,3118,113,115,3126,117,119,3134,121,3142,123,125,3150,127,578,3158,834,1794,3166,65,3174,193,257,3182,385,1793,3190,576,832,3198,1792,3206,1919,958,2055,1918,1917,2063,956,1916,2071,1915,954,2079,1914,2087,1913,952,2095,1912,1911,2103,950,1910,2111,1909,2119,948,1908,2127,1907,946,2135,1906,1905,2143,944,2151,1904,1903,2159,942,1902,2167,1901,940,2175,1900,1899,2183,938,2191,1898,1897,2199,936,1640,2207,1642,1644,2215,1646,2223,1648,1650,2231,1652,1654,2239,1656,1658,2247,1660,2255,1662,1896,2263,1895,934,2271,1638,1894,2279,1893,2287,932,1636,2295,1892,1891,2303,930,1634,2311,1890,1889,2319,928,2327,1632,1888,2335,1887,926,2343,1630,1886,2351,1885,2359,924,1628,2367,1884,1883,2375,922,1626,2383,1882,2391,1881,920,2399,1624,1880,2407,1879,918,2415,1622,2423,1878,1877,2431,916,1620,2439,1876,1875,2447,914,1618,2455,1874,2463,1873,912,2471,1616,1872,2479,1871,1423,2487,1425,2495,1427,1429,2503,1431,1433,2511,1435,1437,2519,1439,2527,1441,1443,2535,1445,1447,2543,1449,1451,2551,1453,2559,1455,1457,2567,1459,1461,2575,1463,1465,2583,1467,1469,2591,1471,2599,910,1614,2607,1870,1421,2615,1869,908,2623,1612,2631,1868,1419,2639,1867,906,2647,1610,1866,2655,1417,2663,1865,904,2671,1608,1864,2679,1289,1291,2687,1293,1295,2695,1297,2703,1299,1301,2711,1303,1305,2719,1307,1309,2727,1311,2735,1313,1315,2743,1317,1319,2751,1321,1323,2759,1325,2767,1327,1329,2775,1331,1333,2783,1335,1337,2791,1339,2799,1341,1343,2807,1287,1415,2815,1863,902,2823,1606,1862,2831,1221,2839,1223,1225,2847,1227,1229,2855,1231,1233,2863,1235,2871,1237,1239,2879,1241,1243,2887,1245,1247,2895,1249,2903,1251,1253,2911,1255,1257,2919,1259,1261,2927,1263,2935,1265,1267,2943,1269,1271,2951,1273,1275,2959,1277,1279,2967,1285,2975,1413,1861,2983,900,1604,2991,1860,1219,2999,1283,3007,1411,1859,3015,1091,1093,3023,1095,1097,3031,1099,3039,1101,1103,3047,1105,1107,3055,1109,1111,3063,1113,3071,1115,1117,3079,1119,1121,3087,1123,1125,3095,1127,1129,3103,1131,3111,1133,1135,3119,1137,1139,3127,1141,1143,3135,1145,3143,1147,1149,3151,1151,898,3159,1602,1858,3167,1089,3175,1217,1281,3183,1409,1857,3191,896,1600,3199,1856,3207};
__device__ const unsigned short ATT_OFF[9] = {0,401,802,1203,1604,2005,2406,2807,3208};


constexpr int RING_OFF = 0, RING_BYTES = 131072, ATT_SCR_OFF = RING_BYTES, LDSCTL_OFF = RING_BYTES + 2048, MISC_OFF = LDSCTL_OFF + 320, ATT_Q_OFF = MISC_OFF + 256, RS_OFF = MISC_OFF + 512, LDS_BYTES = 147456;
constexpr int NWAVES = 8;

#define XB_TMO      128
#define XB_XCNT(j)  (256  + 64 * (j))
#define XB_XSUB(j)  (1280 + 64 * (j))
#define XB_XGEN(j)  (2304 + 64 * (j))
#define XB_TOP      3328
#define XB_TOPGEN   3392
#define XCD_BAR_WORDS 3456
#define XB_SPIN_CAP (1u << 22)
__device__ __forceinline__ unsigned xb_ld(unsigned* p)              { return __hip_atomic_load(p, __ATOMIC_RELAXED, __HIP_MEMORY_SCOPE_AGENT); }
__device__ __forceinline__ unsigned xb_add(unsigned* p, unsigned v) { return __hip_atomic_fetch_add(p, v, __ATOMIC_RELAXED, __HIP_MEMORY_SCOPE_AGENT); }
__device__ __forceinline__ unsigned xb_xcc_id() { return (unsigned)__builtin_amdgcn_s_getreg((3 << 11) | 20) & 0xFu; }
#define XB_SPIN(cond, bar) do { unsigned _sp = 0; while (cond) { __builtin_amdgcn_s_sleep(1); \
    if ((++_sp & 255u) == 0u) { if (xb_ld(&(bar)[XB_TMO])) break; if (_sp > XB_SPIN_CAP) { atomicAdd(&(bar)[XB_TMO], 1u); break; } } } } while (0)
struct XcdBarrier { unsigned* bar; unsigned x; volatile LAS unsigned* st; };
__device__ __forceinline__ XcdBarrier xcd_barrier_post(unsigned* bar, volatile LAS unsigned* st) {
    XcdBarrier b; b.bar = bar; b.x = xb_xcc_id(); b.st = st;
    if (threadIdx.x == 0) (void)xb_add(&bar[XB_XCNT(b.x)], 1u);
    return b;
}
__device__ __forceinline__ void xcd_barrier_complete(unsigned* bar, unsigned x, unsigned& nloc, unsigned& nx) {
    const unsigned G = gridDim.x * gridDim.y * gridDim.z;
    unsigned sum, cnt, mine, sp = 0u;
    for (;;) {
        sum = 0u; cnt = 0u; mine = 0u;
#pragma unroll
        for (unsigned j = 0; j < 16; ++j) { const unsigned c = xb_ld(&bar[XB_XCNT(j)]); sum += c; cnt += (c > 0u) ? 1u : 0u; mine = (j == x) ? c : mine; }
        if (sum == G) break;
        __builtin_amdgcn_s_sleep(1);
        if ((++sp & 255u) == 0u) { if (xb_ld(&bar[XB_TMO])) break; if (sp > XB_SPIN_CAP) { atomicAdd(&bar[XB_TMO], 1u); break; } }
    }
    nloc = mine > 0u ? mine : 1u; nx = cnt > 0u ? cnt : 1u;
}
__device__ __forceinline__ void xcd_barrier(const XcdBarrier& b, const int wave) {
    asm volatile("s_waitcnt vmcnt(0)" ::: "memory");
    __syncthreads();
    if (wave == 0 && lane_id() == 0) {
        unsigned* bar = b.bar;
        __builtin_amdgcn_s_waitcnt(0);
        unsigned nloc = b.st[0], nx = b.st[1];
        if (nloc == 0u) { xcd_barrier_complete(bar, b.x, nloc, nx); b.st[0] = nloc; b.st[1] = nx; }
        const unsigned old = xb_add(&bar[XB_XSUB(b.x)], 1u);
        const unsigned gen = old / nloc;
        if (old + 1u == (gen + 1u) * nloc) {
            __builtin_amdgcn_fence(__ATOMIC_RELEASE, "agent");
            asm volatile("s_waitcnt vmcnt(0)" ::: "memory");
            const unsigned og = xb_add(&bar[XB_TOP], 1u);
            const unsigned tg = og / nx;
            if (og + 1u == (tg + 1u) * nx) xb_add(&bar[XB_TOPGEN], 1u);
            else XB_SPIN(xb_ld(&bar[XB_TOPGEN]) == tg, bar);
            __builtin_amdgcn_fence(__ATOMIC_ACQUIRE, "agent");
            xb_add(&bar[XB_XGEN(b.x)], 1u);
            asm volatile("s_waitcnt vmcnt(0)" ::: "memory");
        } else {
            XB_SPIN(xb_ld(&bar[XB_XGEN(b.x)]) == gen, bar);
            __builtin_amdgcn_fence(__ATOMIC_ACQUIRE, "agent");
            asm volatile("s_waitcnt vmcnt(0)" ::: "memory");
        }
    }
    __syncthreads();
}

template <bool NT> __device__ __forceinline__ void p0_load(f32x4 (&v)[8], const float* W, int N, int k0, int src0, int lane) {
    const int kr = lane >> 3, nc = (lane & 7) * 4;
#pragma unroll
    for (int i = 0; i < 8; ++i) { const GAS f32x4* p = (const GAS f32x4*)(W + (size_t)(k0 + 8 * i + kr) * N + src0 + nc); v[i] = NT ? __builtin_nontemporal_load(p) : *p; }
}
template <bool NTS, bool F8 = false> __device__ __forceinline__ void p0_store(const f32x4 (&v)[8], int K, bf16_t* WT, const float* ksc, LAS float* scr, int k0, int n0, int lane) {
    const int kr = lane >> 3, nc = (lane & 7) * 4;
#pragma unroll
    for (int i = 0; i < 8; ++i) { const int kk = 8 * i + kr; const float sc = (ksc ? ksc[k0 + kk] : 1.f) * (F8 ? F8_SW : 1.f); LAS float* s = scr + kk * 33 + nc;
        s[0] = v[i][0] * sc; s[1] = v[i][1] * sc; s[2] = v[i][2] * sc; s[3] = v[i][3] * sc; }
    asm volatile("s_waitcnt lgkmcnt(0)" ::: "memory");
    const int c = lane & 7;
#pragma unroll
    for (int j = 0; j < 4; ++j) { const int n = (lane >> 3) + 8 * j; const LAS float* s = scr + (8 * c) * 33 + n;
        if constexpr (F8) { u32x2 o; o.x = pk_fp8x4(s[0 * 33], s[1 * 33], s[2 * 33], s[3 * 33]); o.y = pk_fp8x4(s[4 * 33], s[5 * 33], s[6 * 33], s[7 * 33]);
            *(GAS u32x2*)((unsigned char*)WT + (size_t)(n0 + n) * K + k0 + 8 * c) = o; }
        else {
        u32x4 o; o.x = cvt_pk_bf16(s[0 * 33], s[1 * 33]); o.y = cvt_pk_bf16(s[2 * 33], s[3 * 33]); o.z = cvt_pk_bf16(s[4 * 33], s[5 * 33]); o.w = cvt_pk_bf16(s[6 * 33], s[7 * 33]);
        if (NTS) __builtin_nontemporal_store(o, (GAS u32x4*)(WT + (size_t)(n0 + n) * K + k0 + 8 * c)); else *(GAS u32x4*)(WT + (size_t)(n0 + n) * K + k0 + 8 * c) = o; } }
    asm volatile("s_waitcnt lgkmcnt(0)" ::: "memory");
}
template <bool NTS, bool F8 = false> __device__ __forceinline__ void p0_item(const float* W, int N, int K, bf16_t* WT, const float* ksc, LAS float* scr, int k0, int n0, int src0, int lane) {
    f32x4 v[8]; p0_load<true>(v, W, N, k0, src0, lane); p0_store<NTS, F8>(v, K, WT, ksc, scr, k0, n0, lane);
}
template <int GU  > __device__ __forceinline__ void p0_matrix(const float* W, int K, int N, bf16_t* WT, const float* ksc, LAS float* scr, int gw, int NGW, int& base, int lane, bf16_t* WT8 = nullptr) {
    const int nblk = (WT8 ? 5 * D_MODEL : N) / 32, items = (K / 64) * nblk;
    int first = (gw - (base % NGW) + NGW) % NGW;
    for (int it = first; it < items; it += NGW) { const int kb = it / nblk, nb = it % nblk, n0 = nb * 32;
        int src0 = n0; if (GU == 1) { const int pn = n0 >> 8, bj = (n0 >> 7) & 1, ii = n0 & 127; src0 = bj * D_FF + pn * 128 + ii; }
        if (GU == 2 && n0 >= 5 * D_MODEL) { const int r = n0 - 5 * D_MODEL, jt = r >> 8, bj = (r >> 7) & 1, ii = r & 127; src0 = 5 * D_MODEL + bj * D_MODEL + jt * 128 + ii;
            p0_item<false, true>(W, N, K, WT8, ksc, scr, kb * 64, r, src0, lane); continue; }
        p0_item<(GU != 2)>(W, N, K, WT, ksc, scr, kb * 64, n0, src0, lane); }
    base += items;
}

__device__ __forceinline__ void fill_row_scale(LAS float* rs, const float* stat, int pm, int wave, int lane) {
#pragma unroll 8
    for (int i = 0; i < 32; ++i) { const int r = wave * 32 + i; const float s = wave_sum(stat[((size_t)pm * 256 + r) * 64 + lane]); if (lane == 0) rs[r] = rsqrtf(s * (1.f / D_MODEL) + RMS_EPS); }
    asm volatile("s_waitcnt lgkmcnt(0)" ::: "memory"); __syncthreads();
}
struct Args { const float* in[24]; float* out; unsigned char* ws; int ph_lo, ph_hi; };
enum { I_X = 0, I_P, I_GMIX, I_WIN, I_BGATE, I_LNVG, I_LNVB, I_WS, I_BS, I_LQ1, I_LK1, I_LQ2, I_LK2, I_SUBLN, I_WA, I_WB, I_WO, I_GFFN, I_WGU, I_WDOWN, I_GPLE, I_WPG, I_WPP, I_GFINAL };
constexpr int N_PHASES = 10;

typedef __attribute__((address_space(4))) const unsigned char* kptr_t;
__device__ __forceinline__ const float* karg_in(int i) { kptr_t ka = (kptr_t)__builtin_amdgcn_kernarg_segment_ptr(); asm volatile("" : "+s"(ka)); return *(const float* const __attribute__((address_space(4)))*)(ka + 8 * i); }
#define AIN(i) karg_in(i)
constexpr int CV_GU = (D_MODEL / 64) * (2 * D_FF / 32) / 128, CV_DOWN = (D_FF / 64) * (D_MODEL / 32) / 128, CV_SQ = (D_MODEL / 64) * (D_MODEL / 32) / 128, CV_PP = (PLE_DIM / 64) * (D_MODEL / 32) / 128;
constexpr int CV_CHUNKS = CV_GU + CV_DOWN + 4 * CV_SQ + CV_PP;
static_assert((D_MODEL / 64) * (2 * D_FF / 32) % 128 == 0 && (D_FF / 64) * (D_MODEL / 32) % 128 == 0 && (PLE_DIM / 64) * (D_MODEL / 32) % 128 == 0 && CV_CHUNKS == 776, "conversion chunks");
__device__ __forceinline__ void cv_load(f32x4 (&v)[8], float& kv, const float* W, int N, int k0, int src0, const float* kp, int lane) {
    const int kr = lane >> 3, nc = (lane & 7) * 4;
    const float* p = W + (size_t)(k0 + kr) * N + src0 + nc;
#pragma unroll
    for (int i = 0; i < 8; ++i) { v[i] = __builtin_nontemporal_load((const GAS f32x4*)p); p += (size_t)8 * N; }
    kv = *(const GAS float*)kp;
}
template <bool F8> __device__ __forceinline__ void cv_store(const f32x4 (&v)[8], float kv, int K, bf16_t* WT, LAS float* scr, int k0, int n0, int lane) {
    const int kr = lane >> 3, nc = (lane & 7) * 4;
#pragma unroll
    for (int i = 0; i < 8; ++i) { const int kk = 8 * i + kr; const float sc = __builtin_bit_cast(float, __builtin_amdgcn_ds_bpermute(kk * 4, __builtin_bit_cast(int, kv))); LAS float* s = scr + kk * 33 + nc;
        s[0] = v[i][0] * sc; s[1] = v[i][1] * sc; s[2] = v[i][2] * sc; s[3] = v[i][3] * sc; }
    asm volatile("s_waitcnt lgkmcnt(0)" ::: "memory");
    const int c = lane & 7;
#pragma unroll
    for (int j = 0; j < 4; ++j) { const int n = (lane >> 3) + 8 * j; const LAS float* s = scr + (8 * c) * 33 + n;
        if constexpr (F8) {
            u32x2 o; o.x = pk_fp8x4(s[0 * 33], s[1 * 33], s[2 * 33], s[3 * 33]); o.y = pk_fp8x4(s[4 * 33], s[5 * 33], s[6 * 33], s[7 * 33]);
            unsigned char* dst = (unsigned char*)WT + (size_t)(n0 + n) * K + k0 + 8 * c;
            asm volatile("global_store_dwordx2 %0, %1, off" :: "v"(dst), "v"(o) : "memory");
        } else {
        u32x4 o; o.x = cvt_pk_bf16(s[0 * 33], s[1 * 33]); o.y = cvt_pk_bf16(s[2 * 33], s[3 * 33]); o.z = cvt_pk_bf16(s[4 * 33], s[5 * 33]); o.w = cvt_pk_bf16(s[6 * 33], s[7 * 33]);
        bf16_t* dst = WT + (size_t)(n0 + n) * K + k0 + 8 * c;
        asm volatile("global_store_dwordx4 %0, %1, off" :: "v"(dst), "v"(o) : "memory"); } }
    asm volatile("s_waitcnt lgkmcnt(0)" ::: "memory");
}
template <bool F8> __device__ __forceinline__ void conv_body(int c, const float* W, const float* ksc, bf16_t* WT, int K, int N, int gu, LAS float* scr, int wave, int lane, int ndst = 0) {
    const bool has = ksc != nullptr;
    const int nblk = (ndst ? ndst : N) / 32; int it = c * 128 + wave;
#define CV_DECODE(it_, k0_, n0_, s0_) const int k0_ = ((it_) / nblk) * 64, n0_ = ((it_) % nblk) * 32; int s0_ = n0_; { const int pn = n0_ >> 8, bj = (n0_ >> 7) & 1, ii = n0_ & 127; \
        if (gu == 1) s0_ = bj * D_FF + pn * 128 + ii; else if (gu == 2) s0_ = 5 * D_MODEL + bj * D_MODEL + pn * 128 + ii; }
#define CV_LD(v, q, itx) do { CV_DECODE(itx, k0, n0, s0); (void)n0; cv_load(v, q, W, N, k0, s0, has ? ksc + k0 + lane : W, lane); } while (0)
#define CV_ST(v, q, itx, n) do { CV_DECODE(itx, k0, n0, s0); (void)s0; cv_store<F8>(v, (has ? q : 1.f) * (F8 ? F8_SW : 1.f), K, WT, scr, k0, n0, lane); } while (0)
    f32x4 v0[8], v1[8], v2[8], v3[8]; float q0, q1, q2, q3;
    CV_LD(v0, q0, it); CV_LD(v1, q1, it + 8); CV_LD(v2, q2, it + 16);
#pragma unroll
    for (int j = 0; j < 16; j += 4) {
        CV_LD(v3, q3, it + 24);
        CV_ST(v0, q0, it, 27);
        if (j + 4 < 16) { CV_LD(v0, q0, it + 32); CV_ST(v1, q1, it + 8, 27); CV_LD(v1, q1, it + 40); CV_ST(v2, q2, it + 16, 27); CV_LD(v2, q2, it + 48); CV_ST(v3, q3, it + 24, 27); }
        else { CV_ST(v1, q1, it + 8, 18); CV_ST(v2, q2, it + 16, 9); CV_ST(v3, q3, it + 24, 0); }
        it += 32;
    }
#undef CV_DECODE
#undef CV_LD
#undef CV_ST
}
__device__ __forceinline__ void h8_item(int i, unsigned char* ws, int wave, int lane) {
    const bf16_t* hp = (const bf16_t*)(ws + WS_H) + ((size_t)i * 64 + wave * 8) * D_MODEL + lane * 8; unsigned char* op = ws + WS_H8 + ((size_t)i * 64 + wave * 8) * D_MODEL + lane * 8;
#pragma unroll 2
    for (int r = 0; r < 8; ++r) { u32x4 w[8];
#pragma unroll
        for (int j = 0; j < 8; ++j) w[j] = *(const GAS u32x4*)(hp + (size_t)r * D_MODEL + j * 512);
#pragma unroll
        for (int j = 0; j < 8; ++j) { f32x4 a, b2; pg8::unpack8(w[j], a, b2); a = a * F8_SA; b2 = b2 * F8_SA;
            *(GAS u32x2*)(op + (size_t)r * D_MODEL + j * 512) = (u32x2){pk_fp8x4(a[0], a[1], a[2], a[3]), pk_fp8x4(b2[0], b2[1], b2[2], b2[3])}; } }
}
constexpr int CV_WIN8 = (D_MODEL / 64) * (2 * D_MODEL / 32) / 128, CV_H8 = M_TOK / 64, CV_ALL = CV_CHUNKS + CV_WIN8 + CV_H8;
static_assert(CV_ALL == 1160, "memory-bound queue items");
__device__ __forceinline__ void conv_chunk(int c, unsigned char* ws, LAS float* scr, int wave, int lane) {
    if (c >= CV_CHUNKS + CV_WIN8) { h8_item(c - CV_CHUNKS - CV_WIN8, ws, wave, lane); return; }
    if (c >= CV_CHUNKS) { conv_body<true>(c - CV_CHUNKS, AIN(I_WIN), nullptr, (bf16_t*)(ws + WS_WIN8), D_MODEL, IN_TOTAL, 2, scr, wave, lane, 2 * D_MODEL); return; }
    const float* W; const float* ksc = nullptr; bf16_t* WT; int K, N, gu = 0; bool f8 = false;
    if (c < CV_GU) { W = AIN(I_WGU); ksc = AIN(I_GFFN); WT = (bf16_t*)(ws + WS_WGU); K = D_MODEL; N = 2 * D_FF; gu = 1; }
    else if ((c -= CV_GU) < CV_DOWN) { W = AIN(I_WDOWN); WT = (bf16_t*)(ws + WS_WDOWN); K = D_FF; N = D_MODEL; }
    else if ((c -= CV_DOWN) < 4 * CV_SQ) { const int m = c / CV_SQ; c -= m * CV_SQ; W = AIN(m < 3 ? I_WA + m : I_WPG); if (m == 3) { ksc = AIN(I_GPLE); f8 = true; } WT = (bf16_t*)(ws + WS_WA + (size_t)m * (WS_WB - WS_WA)); K = D_MODEL; N = D_MODEL; }
    else { c -= 4 * CV_SQ; W = AIN(I_WPP); WT = (bf16_t*)(ws + WS_WPP); K = PLE_DIM; N = D_MODEL; }
    if (f8) conv_body<true>(c, W, ksc, WT, K, N, gu, scr, wave, lane);
    else conv_body<false>(c, W, ksc, WT, K, N, gu, scr, wave, lane);
}
static_assert(WS_WB - WS_WA == WS_WO - WS_WB && WS_WO - WS_WB == WS_WPG - WS_WO && I_WB == I_WA + 1 && I_WO == I_WA + 2, "the four square weights are addressed by index");
__global__ void __launch_bounds__(NWAVES * 64, 2) mk_fwd(Args args) {
    extern __shared__ __attribute__((aligned(16))) unsigned char lds_raw[];
    LAS unsigned char* lds = (LAS unsigned char*)lds_raw;
    volatile LAS unsigned* MISC = (volatile LAS unsigned*)(lds + MISC_OFF);
    const int wave = __builtin_amdgcn_readfirstlane((int)threadIdx.x >> 6);
#define LANE_HERE() int lane = lane_id(); asm volatile("" : "+v"(lane)); const int tid = wave * 64 + lane; (void)tid;
    const int G = gridDim.x; const int bx = blockIdx.x; const int vcu = (G % 8 == 0) ? (bx % 8) * (G / 8) + bx / 8 : bx;
    unsigned char* ws = args.ws;
    unsigned* ctl = (unsigned*)(ws + WS_CTL);
    for (int u = threadIdx.x; u < (LDS_BYTES - LDSCTL_OFF) / 4; u += NWAVES * 64) ((LAS unsigned*)(lds + LDSCTL_OFF))[u] = 0u;
    __syncthreads();
    const int lo = args.ph_lo, hi = args.ph_hi;
    XcdBarrier bar; bar.bar = ctl + CW_BAR; bar.x = 0; bar.st = nullptr;
    if (hi - lo > 1) bar = xcd_barrier_post(ctl + CW_BAR, MISC + 8);
#ifndef PHASE_MASK
#define PHASE_MASK 0x3ff
#endif
#define IN(k) ((((PHASE_MASK) >> (k)) & 1) && lo <= (k) && (k) < hi)
#define BOTH(k) (IN(k) && IN((k) + 1))
#ifndef REP_MASK
#define REP_MASK 0
#endif
#define NREP(k) ((((REP_MASK) >> (k)) & 1) ? 2 : 1)
#define WIN ((bf16_t*)(ws + WS_WIN))
#define WGU ((bf16_t*)(ws + WS_WGU))
#define WDOWN ((bf16_t*)(ws + WS_WDOWN))
#define WA ((bf16_t*)(ws + WS_WA))
#define WB ((bf16_t*)(ws + WS_WB))
#define WO ((bf16_t*)(ws + WS_WO))
#define WPG ((bf16_t*)(ws + WS_WPG))
#define WPP ((bf16_t*)(ws + WS_WPP))
#define HB ((bf16_t*)(ws + WS_H))
#define PB ((bf16_t*)(ws + WS_PB))
#define STATV ((float*)(ws + WS_STATV))
#define STAT1 ((float*)(ws + WS_STAT1))
#define STAT2 ((float*)(ws + WS_STAT2))
#define STAT3 ((float*)(ws + WS_STAT3))

    if (IN(0)) {
        LANE_HERE();
        LAS float* scr = (LAS float*)(lds + RING_OFF + wave * 16384);
#pragma unroll 1
        for (int rep = 0; rep < NREP(0); ++rep) {
        const int gw = vcu * NWAVES + wave, NGW = G * NWAVES; int base = 0;
        p0_matrix<2>(AIN(I_WIN), D_MODEL, IN_TOTAL, WIN, nullptr, scr, gw, NGW, base, lane, (bf16_t*)(ws + WS_WIN8));
        const float* gm = AIN(I_GMIX);
        for (int m = gw; m < M_TOK; m += NGW) {
            const GAS f32x4* xr = (const GAS f32x4*)(AIN(I_X) + (size_t)m * D_MODEL) + lane;
            f32x4 v[16]; float s = 0.f;
#pragma unroll
            for (int j = 0; j < 16; ++j) { v[j] = __builtin_nontemporal_load(xr + 64 * j); s += pg8::hsq4(v[j]); }
            const float rstd = rsqrtf(wave_sum(s) * (1.f / D_MODEL) + RMS_EPS);
            GAS u32x2* o8 = (GAS u32x2*)(HB + (size_t)m * D_MODEL) + lane;
#pragma unroll
            for (int j = 0; j < 16; ++j) { const f32x4 gv = *((const GAS f32x4*)gm + lane + 64 * j); u32x2 w; const f32x4 hv = v[j] * rstd * gv;
                w.x = cvt_pk_bf16(hv[0], hv[1]); w.y = cvt_pk_bf16(hv[2], hv[3]); o8[64 * j] = w; }
        }
        { const size_t n4 = (size_t)M_TOK * PLE_DIM / 4; const GAS f32x4* src = (const GAS f32x4*)AIN(I_P); GAS u32x2* dst = (GAS u32x2*)PB;
          for (size_t i = (size_t)gw * 64 + lane; i < n4; i += (size_t)NGW * 64) { const f32x4 v = __builtin_nontemporal_load(src + i); u32x2 w; w.x = cvt_pk_bf16(v[0], v[1]); w.y = cvt_pk_bf16(v[2], v[3]); dst[i] = w; } }
        }
        if (BOTH(0)) xcd_barrier(bar, wave);
    }
    if (IN(1)) {
        pg8::Gemm g{HB, WIN, HB, WIN, M_TOK, 5 * D_MODEL, D_MODEL, D_MODEL, D_MODEL / 64}; pg8::StaticOrder S; S.init(M_TOK, 5 * D_MODEL, G, bx);
        pg8::EpiProj E{(bf16_t*)(ws + WS_ACT), STATV, ctl + CW_KN};
#ifdef PROBE_EPI
        { pg8::EpiProbe<PROBE_EPI> EP{(bf16_t*)(ws + WS_ACT)}; pg8::gemm_phase<pg8::EpiProbe<PROBE_EPI>, pg8::StaticOrder, true, true>(lds + RING_OFF, g, S, EP, wave); }
#endif
#pragma unroll 1
        for (int rep = 0; rep < NREP(1); ++rep)
        pg8::gemm_phase<pg8::EpiProj, pg8::StaticOrder, true, true>(lds + RING_OFF, g, S, E, wave);
        if (BOTH(1)) xcd_barrier(bar, wave);
    }
    if (IN(2)) {
        LANE_HERE();
        bf16_t* GU = (bf16_t*)(ws + WS_GU); const bf16_t* GV = (const bf16_t*)(ws + WS_GV);
        constexpr int TST = 272;
        LAS unsigned char* Tl = lds; LAS unsigned char* Wl = lds + 65536; LAS f32x2* stl = (LAS f32x2*)(lds + 65536 + 128 * TST);
        const int tvb = (int)(uintptr_t)(lds) + att::v_rd_base(lane) + (wave & 3) * 512 + (wave >> 2) * 16384;
        const int r32 = lane & 31, hi5 = lane >> 5;
        int cur_g = -1;
#pragma unroll 1
        for (int rep = 0; rep < NREP(2); ++rep)
#pragma unroll 1
        for (int ui = 0; ui * G + vcu < (M_TOK / CHUNK) * GROUPS; ++ui) {
            const int uid = ui * G + vcu, gq = (G % 16 == 0) ? (vcu & 15) : (uid & 15), cbk = (G % 16 == 0) ? ((vcu >> 4) + (G >> 4) * ui) : (uid >> 4); const size_t R0 = (size_t)cbk * CHUNK;
            bf16_t* YO = (NREP(2) == 2 && rep == 0) ? HB : GU;
            f32x4 sp[8];
            { const f32x4* p = (const f32x4*)(STATV + (R0 + (tid >> 2)) * 128 + (tid & 3) * 32);
#pragma unroll
              for (int i = 0; i < 8; ++i) sp[i] = p[i]; }
            u32x4 gvw[8];
            const int c8 = (tid & 31) * 8;
#pragma unroll
            for (int i = 0; i < 8; ++i) gvw[i] = *(const u32x4*)(GV + (R0 + ((i * 512 + tid) >> 5)) * D_MODEL + gq * 256 + c8);
            u32x2 guw[4][4];
#pragma unroll
            for (int j = 0; j < 4; ++j)
#pragma unroll
                for (int q4 = 0; q4 < 4; ++q4) guw[j][q4] = *(const u32x2*)(GU + (R0 + 32 * j + r32) * D_MODEL + gq * 256 + 32 * wave + 4 * hi5 + 8 * q4);
            const float* lg = AIN(I_LNVG) + gq * 256 + c8; const float* lb = AIN(I_LNVB) + gq * 256 + c8;
            const f32x4 g0 = *(const f32x4*)lg, g1 = *(const f32x4*)(lg + 4), b0 = *(const f32x4*)lb, b1 = *(const f32x4*)(lb + 4);
            if (gq != cur_g) {
                __syncthreads();
                const float* Wg = AIN(I_WS) + (size_t)gq * CHUNK * CHUNK;
#pragma unroll
                for (int i = 0; i < 8; ++i) { const int idx = i * 512 + tid, t = idx >> 5, s4 = (idx & 31) * 4; const f32x4 v = *(const f32x4*)(Wg + t * CHUNK + s4);
                    u32x2 w; w.x = cvt_pk_bf16(s4 + 0 <= t ? v[0] : 0.f, s4 + 1 <= t ? v[1] : 0.f); w.y = cvt_pk_bf16(s4 + 2 <= t ? v[2] : 0.f, s4 + 3 <= t ? v[3] : 0.f);
                    *(LAS u32x2*)(Wl + t * TST + s4 * 2) = w; }
                cur_g = gq;
            }
            { float sm = 0.f, sq = 0.f;
#pragma unroll
              for (int i = 0; i < 8; ++i) { sm += sp[i][0] + sp[i][2]; sq += sp[i][1] + sp[i][3]; }
              sm += swz_xor<1>(sm); sm += swz_xor<2>(sm); sq += swz_xor<1>(sq); sq += swz_xor<2>(sq);
              const float mean = sm * (1.f / D_MODEL), var = sq * (1.f / D_MODEL) - mean * mean;
              if ((tid & 3) == 0) stl[tid >> 2] = (f32x2){mean, rsqrtf(var + LN_EPS)}; }
            __syncthreads();
#pragma unroll
            for (int i = 0; i < 8; ++i) { const int sr = (i * 512 + tid) >> 5; f32x4 v0, v1; pg8::unpack8(gvw[i], v0, v1); const f32x2 st = stl[sr];
                v0 = (v0 - st.x) * st.y * g0 + b0; v1 = (v1 - st.x) * st.y * g1 + b1;
                const int sk = sr & 63, kk = (sk & ~0xC) | ((sk & 4) << 1) | ((sk & 8) >> 1), cc = c8 & 127;
                *(LAS u32x4*)(Tl + ((sr >> 6) * 2 + (c8 >> 7)) * 16384 + ((kk >> 3) * 4 + (cc >> 5)) * 512 + ((kk & 7) * 32 + (cc & 31)) * 2) = pg8::pack8(v0, v1); }
            __syncthreads();
            f32x16 acc[4];
#pragma unroll
            for (int j = 0; j < 4; ++j) acc[j] = (f32x16){0.f, 0.f, 0.f, 0.f, 0.f, 0.f, 0.f, 0.f, 0.f, 0.f, 0.f, 0.f, 0.f, 0.f, 0.f, 0.f};
#pragma unroll
            for (int ks = 0; ks < 8; ++ks) {
                s16x4 tl_, th_;
                switch (ks) {
                    case 0: tl_ = att::tr_read<0>(tvb); th_ = att::tr_read<2048>(tvb); break;
                    case 1: tl_ = att::tr_read<4096>(tvb); th_ = att::tr_read<6144>(tvb); break;
                    case 2: tl_ = att::tr_read<8192>(tvb); th_ = att::tr_read<10240>(tvb); break;
                    case 3: tl_ = att::tr_read<12288>(tvb); th_ = att::tr_read<14336>(tvb); break;
                    case 4: tl_ = att::tr_read<32768>(tvb); th_ = att::tr_read<34816>(tvb); break;
                    case 5: tl_ = att::tr_read<36864>(tvb); th_ = att::tr_read<38912>(tvb); break;
                    case 6: tl_ = att::tr_read<40960>(tvb); th_ = att::tr_read<43008>(tvb); break;
                    default: tl_ = att::tr_read<45056>(tvb); th_ = att::tr_read<47104>(tvb); break;
                }
                asm volatile("s_waitcnt lgkmcnt(0)" ::: "memory"); __builtin_amdgcn_sched_barrier(0);
                const bf16x8 a = (bf16x8){tl_[0], tl_[1], tl_[2], tl_[3], th_[0], th_[1], th_[2], th_[3]};
#pragma unroll
                for (int j = 0; j < 4; ++j) if (16 * ks <= 32 * j + 31) { const bf16x8 bw = *(const LAS bf16x8*)(Wl + (32 * j + r32) * TST + (16 * ks + 8 * hi5) * 2);
                    acc[j] = __builtin_amdgcn_mfma_f32_32x32x16_bf16(a, bw, acc[j], 0, 0, 0); } }
            const float* bsg = AIN(I_BS) + gq * CHUNK;
#pragma unroll
            for (int j = 0; j < 4; ++j) { const int t = 32 * j + r32; const float bsv = bsg[t]; bf16_t* yp = YO + (R0 + t) * D_MODEL + gq * 256 + 32 * wave + 4 * hi5;
#pragma unroll
                for (int q4 = 0; q4 < 4; ++q4) { const u32x2 w = guw[j][q4]; const f32x2 ga = pg8::gelu_pk((f32x2){bflo(w.x), bfhi(w.x)}), gb = pg8::gelu_pk((f32x2){bflo(w.y), bfhi(w.y)});
                    u32x2 o; o.x = cvt_pk_bf16(ga.x * (acc[j][4 * q4 + 0] + bsv), ga.y * (acc[j][4 * q4 + 1] + bsv)); o.y = cvt_pk_bf16(gb.x * (acc[j][4 * q4 + 2] + bsv), gb.y * (acc[j][4 * q4 + 3] + bsv));
                    *(u32x2*)(yp + 8 * q4) = o; } }
        }
        __syncthreads();
    }
    if (IN(3)) {
        LANE_HERE();
        float lam;
        { const float a = wave_sum(AIN(I_LQ1)[lane] * AIN(I_LK1)[lane] + AIN(I_LQ1)[lane + 64] * AIN(I_LK1)[lane + 64]);
          const float c = wave_sum(AIN(I_LQ2)[lane] * AIN(I_LK2)[lane] + AIN(I_LQ2)[lane + 64] * AIN(I_LK2)[lane + 64]);
          lam = sgpr_f(__expf(a) - __expf(c) + LAM_INIT); }
        const bf16_t* Qp = (const bf16_t*)(ws + WS_Q); const bf16_t* Kp = (const bf16_t*)(ws + WS_K); const bf16_t* Vp = (const bf16_t*)(ws + WS_V);
        LAS int* qslot = (LAS int*)(lds + ATT_Q_OFF);
        const unsigned myx = xb_xcc_id() & 7u;
#pragma unroll 1
        for (int rep = 0; rep < NREP(3); ++rep) {
        int li = 0;
#pragma unroll 1
        for (;;) {
            if (wave == 0 && lane_id() == 0) { int item = -1;
                while (li < 8) { const unsigned x = (myx + (unsigned)li) & 7u; const unsigned idx = __hip_atomic_fetch_add(ctl + CW_ATTQ + rep * 512 + 64 * x, 1u, __ATOMIC_RELAXED, __HIP_MEMORY_SCOPE_AGENT);
                    if (idx < (unsigned)(ATT_OFF[x + 1] - ATT_OFF[x])) { item = ATT_ITEMS[ATT_OFF[x] + idx]; break; } ++li; }
                *qslot = item; }
            ATT_BAR();
            const int item = __builtin_amdgcn_readfirstlane(*qslot);
            if (item < 0) break;
            int l2 = lane_id(); asm volatile("" : "+v"(l2));
            if (item >= 2048) { __builtin_amdgcn_s_waitcnt(0); ATT_BAR(); conv_chunk(item - 2048, ws, (LAS float*)(lds + RING_OFF + wave * 16384), wave, l2); continue; }
            const int b = item >> 10, h = (item >> 6) & 15, qbk = item & 63;
            const float slope2 = sgpr_f(exp2f(-0.5f * (float)(h + 1)) * 1.4426950408889634f);
#ifdef ATT_PROBE_VAR
            if (NREP(3) == 2 && rep == 0) att::attn_unit<ATT_PROBE_VAR>(lds + RING_OFF, (LAS float*)(lds + ATT_SCR_OFF), Qp, Kp, Vp, (bf16_t*)(ws + WS_H), b, h, qbk, lam, slope2, AIN(I_SUBLN), ctl + CW_KN, wave, lane);
            else
#endif
            att::attn_unit<0>(lds + RING_OFF, (LAS float*)(lds + ATT_SCR_OFF), Qp, Kp, Vp, (bf16_t*)(ws + ((NREP(3) == 2 && rep == 0) ? WS_H : WS_Q)), b, h, qbk, lam, slope2, AIN(I_SUBLN), ctl + CW_KN, wave, l2);
        }
        }
        if (BOTH(3)) xcd_barrier(bar, wave);
    }
    if (IN(4)) {
        { const bf16_t* A8 = (const bf16_t*)(ws + WS_H8); const bf16_t* B8 = (const bf16_t*)(ws + WS_WIN8);
          pg8::Gemm g8{A8, B8, A8, B8, M_TOK, 2 * D_MODEL, D_MODEL / 2, D_MODEL / 2, D_MODEL / 128}; pg8::StaticOrder S8; S8.init(M_TOK, 2 * D_MODEL, G, bx);
          pg8::EpiGates E8{(bf16_t*)(ws + WS_ACT), AIN(I_BGATE)};
#if PROBE_NULLEPI & 4
          { pg8::EpiNull EN; pg8::gemm_phase<pg8::EpiNull, pg8::StaticOrder, true, true, true>(lds + RING_OFF, g8, S8, EN, wave); }
#endif
#pragma unroll 1
          for (int rep = 0; rep < NREP(11); ++rep)
          pg8::gemm_phase<pg8::EpiGates, pg8::StaticOrder, true, true, true>(lds + RING_OFF, g8, S8, E8, wave); }
        if (hi - lo > 1) xcd_barrier(bar, wave);
        { pg8::Gemm g{(const bf16_t*)(ws + WS_GU), WA, (const bf16_t*)(ws + WS_Q), WB, M_TOK, D_MODEL, 2 * D_MODEL, D_MODEL, D_MODEL / 64}; pg8::PanelOrder<2> S; S.init(M_TOK, G, bx);
          pg8::EpiMerge E{(const bf16_t*)(ws + WS_SA), (const bf16_t*)(ws + WS_SB), (bf16_t*)(ws + WS_MERGED)};
#if PROBE_NULLEPI & 1
          { pg8::EpiNull EN; pg8::gemm_phase<pg8::EpiNull, pg8::PanelOrder<2>, true, true>(lds + RING_OFF, g, S, EN, wave); }
#endif
#pragma unroll 1
          for (int rep = 0; rep < NREP(4); ++rep)
          pg8::gemm_phase<pg8::EpiMerge, pg8::PanelOrder<2>, true, true>(lds + RING_OFF, g, S, E, wave); }
        if (BOTH(4)) xcd_barrier(bar, wave);
    }
    if (IN(5)) {
        pg8::Gemm g{(const bf16_t*)(ws + WS_MERGED), WO, (const bf16_t*)(ws + WS_MERGED), WO, M_TOK, D_MODEL, D_MODEL, D_MODEL, D_MODEL / 64}; pg8::StaticOrder S; S.init(M_TOK, D_MODEL, G, bx);
        pg8::EpiResF32 E{AIN(I_X), HB, STAT1};
#if PROBE_NULLEPI & 2
        { pg8::EpiNull EN; pg8::gemm_phase<pg8::EpiNull, pg8::StaticOrder, true, true>(lds + RING_OFF, g, S, EN, wave); }
#endif
#pragma unroll 1
        for (int rep = 0; rep < NREP(5); ++rep)
        pg8::gemm_phase<pg8::EpiResF32, pg8::StaticOrder, true, true>(lds + RING_OFF, g, S, E, wave);
        if (BOTH(5)) xcd_barrier(bar, wave);
    }
    if (IN(6)) {
        pg8::Gemm g{HB, WGU, HB, WGU, M_TOK, 2 * D_FF, D_MODEL, D_MODEL, D_MODEL / 64}; pg8::StaticOrder S; S.init(M_TOK, 2 * D_FF, G, bx);
        pg8::Unit u0; const bool any = S.next(0, u0); { LANE_HERE(); if (any) fill_row_scale((LAS float*)(lds + RS_OFF), STAT1, u0.pm, wave, lane); }
        pg8::EpiSwiglu E{pg8::RowScale{(const LAS float*)(lds + RS_OFF), any ? u0.pm : -1, STAT1}, (bf16_t*)(ws + WS_HID)};
#pragma unroll 1
        for (int rep = 0; rep < NREP(6); ++rep)
        pg8::gemm_phase<pg8::EpiSwiglu, pg8::StaticOrder, true, true>(lds + RING_OFF, g, S, E, wave);
        { const int nwg6 = (M_TOK / 256) * (2 * D_FF / 256), rem = nwg6 % G, nw = rem ? G - rem : G, me = rem ? bx - rem : bx;
          if (me >= 0) { pg8::Gemm g2{PB, WPP, PB, WPP, M_TOK, D_MODEL, PLE_DIM, PLE_DIM, PLE_DIM / 64}; pg8::StaticOrder S2; S2.init(M_TOK, D_MODEL, nw, me);
            pg8::EpiPlain E2{(bf16_t*)(ws + WS_PP), D_MODEL};
#pragma unroll 1
            for (int rep = 0; rep < NREP(10); ++rep)
            pg8::gemm_phase<pg8::EpiPlain, pg8::StaticOrder, true, true>(lds + RING_OFF, g2, S2, E2, wave); } }
        if (BOTH(6)) xcd_barrier(bar, wave);
    }
    if (IN(7)) {
        pg8::Gemm g{(const bf16_t*)(ws + WS_HID), WDOWN, (const bf16_t*)(ws + WS_HID), WDOWN, M_TOK, D_MODEL, D_FF, D_FF, D_FF / 64}; pg8::PanelOrder<2> S; S.init(M_TOK, G, bx);
#pragma unroll 1
        for (int rep = 0; rep < NREP(7); ++rep) {
        pg8::EpiResBf E{HB, STAT2, (NREP(7) == 2 && rep == 0) ? (bf16_t*)(ws + WS_X3) : HB, ws + WS_X8};
        pg8::gemm_phase<pg8::EpiResBf, pg8::PanelOrder<2>, true, true>(lds + RING_OFF, g, S, E, wave); }
        if (BOTH(7)) xcd_barrier(bar, wave);
    }
    if (IN(8)) {
        const bf16_t* A8 = (const bf16_t*)(ws + WS_X8);
        pg8::Gemm g{A8, WPG, A8, WPG, M_TOK, D_MODEL, D_MODEL / 2, D_MODEL / 2, D_MODEL / 128}; pg8::StaticOrder S; S.init(M_TOK, D_MODEL, G, bx);
        pg8::Unit u0; const bool any = S.next(0, u0); { LANE_HERE(); if (any) fill_row_scale((LAS float*)(lds + RS_OFF), STAT2, u0.pm, wave, lane); }
        pg8::EpiPle E{pg8::RowScale{(const LAS float*)(lds + RS_OFF), any ? u0.pm : -1, STAT2}, HB, (const bf16_t*)(ws + WS_PP), (bf16_t*)(ws + WS_X3), STAT3};
#pragma unroll 1
        for (int rep = 0; rep < NREP(8); ++rep)
        pg8::gemm_phase<pg8::EpiPle, pg8::StaticOrder, true, true, true>(lds + RING_OFF, g, S, E, wave);
        if (BOTH(8)) xcd_barrier(bar, wave);
    }
    if (IN(9)) {
        LANE_HERE();
        const int gw = vcu * NWAVES + wave, NGW = G * NWAVES; const float* gf = AIN(I_GFINAL);
        const unsigned tmo = __hip_atomic_load(ctl + CW_BAR + XB_TMO, __ATOMIC_RELAXED, __HIP_MEMORY_SCOPE_AGENT);
        for (int m = gw; m < M_TOK; m += NGW) {
            float s = STAT3[(size_t)m * 64 + lane]; s = wave_sum(s);
            float rstd = rsqrtf(s * (1.f / D_MODEL) + RMS_EPS); if (tmo) rstd = __builtin_nanf("");
            GAS f32x4* xr = (GAS f32x4*)(args.out + (size_t)m * D_MODEL) + lane; const GAS u32x2* x3 = (const GAS u32x2*)((const bf16_t*)(ws + WS_X3) + (size_t)m * D_MODEL) + lane;
#pragma unroll
            for (int j = 0; j < 16; ++j) { const u32x2 w = x3[64 * j]; const f32x4 v = (f32x4){bflo(w.x), bfhi(w.x), bflo(w.y), bfhi(w.y)}; const f32x4 gv = *((const GAS f32x4*)gf + lane + 64 * j); xr[64 * j] = v * rstd * gv; }
        }
    }
#undef IN
#undef BOTH
}

extern "C" void kernel_launch(void* const* d_in, const int* in_sizes, int n_in, void* d_out, int out_size, void* d_ws, size_t ws_size, hipStream_t stream) {
    static int grid = 0;
    if (grid == 0) {
        if (n_in != 24 || out_size != M_TOK * D_MODEL || ws_size < WS_END) { fprintf(stderr, "kernel_launch: unexpected shapes (n_in %d, out %d, ws %zu < %zu)\n", n_in, out_size, ws_size, (size_t)WS_END); grid = -1; return; }
        int dev = 0, cus = 0, per_cu = 0;
        if (hipGetDevice(&dev) != hipSuccess || hipDeviceGetAttribute(&cus, hipDeviceAttributeMultiprocessorCount, dev) != hipSuccess) { grid = -1; return; }
        if (hipFuncSetAttribute((const void*)mk_fwd, hipFuncAttributeMaxDynamicSharedMemorySize, LDS_BYTES) != hipSuccess) { fprintf(stderr, "kernel_launch: hipFuncSetAttribute failed\n"); grid = -1; return; }
        if (hipOccupancyMaxActiveBlocksPerMultiprocessor(&per_cu, (const void*)mk_fwd, NWAVES * 64, LDS_BYTES) != hipSuccess || per_cu < 1) { fprintf(stderr, "kernel_launch: occupancy query says %d\n", per_cu); }
        (void)hipGetLastError();
        grid = cus;
    }
    if (grid < 0) return;
    (void)hipMemsetAsync((char*)d_ws + WS_CTL, 0, CTL_ZERO_BYTES, stream);
    Args a{};
    for (int i = 0; i < 24; ++i) a.in[i] = (const float*)d_in[i];
    a.out = (float*)d_out; a.ws = (unsigned char*)d_ws;
#if DBG_CHECK
    for (int k = 0; k < N_PHASES; ++k) { a.ph_lo = k; a.ph_hi = k + 1; hipLaunchKernelGGL(mk_fwd, dim3(grid), dim3(NWAVES * 64), LDS_BYTES, stream, a); }
#else
    a.ph_lo = 0; a.ph_hi = N_PHASES;
    hipLaunchKernelGGL(mk_fwd, dim3(grid), dim3(NWAVES * 64), LDS_BYTES, stream, a);
#endif
}
```

```cpp
#include <hip/hip_runtime.h>
#include <cstdio>
#include <cstdint>

#ifndef PROBE_NULLEPI
#define PROBE_NULLEPI 0
#endif
#ifndef DBG_CHECK
#define DBG_CHECK 0
#endif

#define LAS __attribute__((address_space(3)))
#define GAS __attribute__((address_space(1)))
typedef unsigned short bf16_t;
typedef short bf16x8 __attribute__((ext_vector_type(8)));
typedef short s16x4 __attribute__((ext_vector_type(4)));
typedef float f32x4 __attribute__((ext_vector_type(4)));
typedef float f32x2 __attribute__((ext_vector_type(2)));
typedef float f32x16 __attribute__((ext_vector_type(16)));
typedef unsigned u32x4 __attribute__((ext_vector_type(4)));
typedef unsigned u32x2 __attribute__((ext_vector_type(2)));
typedef int i32x4 __attribute__((ext_vector_type(4)));
typedef int i32x8 __attribute__((ext_vector_type(8)));

constexpr int D_MODEL = 4096, BATCH = 2, SEQ = 8192, M_TOK = BATCH * SEQ;
constexpr int PLE_DIM = 256, HEAD_DIM = 128, N_HEADS = 16, V_HEAD_DIM = 256;
constexpr int D_FF = 11008, IN_TOTAL = 28672, CHUNK = 128, GROUPS = 16;
constexpr float RMS_EPS = 1e-6f, LN_EPS = 1e-5f, LAM_INIT = 0.2f;
constexpr float QSCALE = 0.08838834764831845f * 1.4426950408889634f;

typedef __bf16 bf16x2_t __attribute__((ext_vector_type(2)));
__device__ __forceinline__ unsigned cvt_pk_bf16(float lo, float hi) { const f32x2 v = {lo, hi}; const bf16x2_t r = __builtin_convertvector(v, bf16x2_t); return __builtin_bit_cast(unsigned, r); }
__device__ __forceinline__ unsigned pk_fp8x4(float a, float b, float c, float d) {
    a = __builtin_amdgcn_fmed3f(a, -448.f, 448.f); b = __builtin_amdgcn_fmed3f(b, -448.f, 448.f); c = __builtin_amdgcn_fmed3f(c, -448.f, 448.f); d = __builtin_amdgcn_fmed3f(d, -448.f, 448.f);
    int w = __builtin_amdgcn_cvt_pk_fp8_f32(a, b, 0, false); w = __builtin_amdgcn_cvt_pk_fp8_f32(c, d, w, true); return (unsigned)w; }
constexpr float F8_SA = 16.f, F8_SW = 1024.f, F8_DESC = 1.f / (16.f * 1024.f);
__device__ __forceinline__ float bf2f(unsigned short b) { return __uint_as_float(((unsigned)b) << 16); }
__device__ __forceinline__ float bflo(unsigned w) { return __uint_as_float(w << 16); }
__device__ __forceinline__ float bfhi(unsigned w) { return __uint_as_float(w & 0xffff0000u); }
template <int K> __device__ __forceinline__ float swz_xor(float v) { return __int_as_float(__builtin_amdgcn_ds_swizzle(__float_as_int(v), (K << 10) | 0x1f)); }
__device__ __forceinline__ float half_sum(float v) { v += swz_xor<1>(v); v += swz_xor<2>(v); v += swz_xor<4>(v); v += swz_xor<8>(v); v += swz_xor<16>(v); return v; }
__device__ __forceinline__ float wave_sum(float v) { v = half_sum(v); auto rr = __builtin_amdgcn_permlane32_swap(__float_as_uint(v), __float_as_uint(v), false, false); return __uint_as_float(rr[0]) + __uint_as_float(rr[1]); }
__device__ __forceinline__ float sgpr_f(float v) { return __uint_as_float(__builtin_amdgcn_readfirstlane(__float_as_uint(v))); }
__device__ __forceinline__ int lane_id() { int l; asm volatile("v_mbcnt_lo_u32_b32 %0, -1, 0\n\tv_mbcnt_hi_u32_b32 %0, -1, %0" : "=v"(l)); return l; }
__device__ __forceinline__ float sigm(float x) { return __builtin_amdgcn_rcpf(1.f + __builtin_amdgcn_exp2f(-1.4426950408889634f * x)); }

namespace pg8 {
constexpr int BM = 256, BK = 64, HALF = 128, HTB = HALF * BK * 2, STAGE_BYTES = 8 * HTB, NXCD = 8, WGM = 8;
__host__ __device__ __forceinline__ int lds_byte(int r, int c) { const int st = (r >> 4) * 2 + (c >> 5), rr = r & 15, cc = c & 31, ob = rr * 64 + cc * 2; return st * 1024 + (ob ^ (((ob >> 9) & 1) << 5)); }
__host__ __device__ __forceinline__ void stage_rc(int b, int& R, int& C) { const int st = b / 1024, sb = b % 1024, swz = sb ^ (((sb >> 9) & 1) << 5); R = (st >> 1) * 16 + swz / 64; C = (st & 1) * 32 + (swz % 64) / 2; }
__host__ __device__ __forceinline__ int perm32(int rho) { const int n = rho >> 4, i = rho & 15; return 8 * (i >> 2) + 4 * n + (i & 3); }

struct Unit { int pm, pn; };
struct Gemm { const bf16_t* A; const bf16_t* Bt; const bf16_t* A2; const bf16_t* Bt2; int M, N, K, ld, nt1; };

struct StaticOrder {
    int nM, nN, nwg, G, c;
    __host__ __device__ void init(int M, int N, int G_, int c_) { nM = M / BM; nN = N / BM; nwg = nM * nN; G = G_; c = c_; }
    __host__ __device__ bool next(int i, Unit& u) const {
        const long L = (long)i * G + c; if (L >= nwg) return false;
        int wgid = (int)L; { const int q = nwg / NXCD, r = nwg % NXCD, xcd = wgid % NXCD, off = wgid / NXCD; wgid = (xcd < r ? xcd * (q + 1) : r * (q + 1) + (xcd - r) * q) + off; }
        const int nig = WGM * nN, gid = wgid / nig, fm = gid * WGM, gsz = (nM - fm) < WGM ? (nM - fm) : WGM;
        u.pm = fm + ((wgid % nig) % gsz); u.pn = (wgid % nig) / gsz; return true;
    }
};

template <int PA> struct PanelOrder {
    int nM, G, c, NX;
    __host__ __device__ void init(int M, int G_, int c_) { nM = M / BM; G = G_; c = c_; NX = (G % NXCD == 0 && nM % NXCD == 0) ? NXCD : 1; }
    __host__ __device__ bool next(int i, Unit& u) const {
        const int per = G / NX, x = c % NX, r = c / NX, ppx = nM / NX;
        const int idx = i * per + r;
        const int blk = idx / (PA * 16), w = idx % (PA * 16), pl = blk * PA + w / 16;
        if (pl >= ppx) return false;
        u.pm = x * ppx + pl; u.pn = w % 16; return true;
    }
};
__device__ __forceinline__ f32x2 gelu_pk(f32x2 v) {
    const f32x2 av = __builtin_elementwise_abs(v), d = av * 0.2316418882f + 1.0f;
    f32x2 t; t.x = __builtin_amdgcn_rcpf(d.x); t.y = __builtin_amdgcn_rcpf(d.y);
    f32x2 q = t * 0.5307027145f + (-0.7265760135f); q = q * t + 0.7107068705f; q = q * t + (-0.142248368f); q = q * t + 0.127414796f; q = q * t;
    const f32x2 s = (v * v) * (-0.72134752044f);
    f32x2 e; e.x = __builtin_amdgcn_exp2f(s.x); e.y = __builtin_amdgcn_exp2f(s.y);
    const f32x2 m = v * (q * e), r = v - m;
    f32x2 o; o.x = v.x < 0.f ? m.x : r.x; o.y = v.y < 0.f ? m.y : r.y; return o;
}
__device__ __forceinline__ f32x4 gelu4(f32x4 v) { const f32x2 a = gelu_pk((f32x2){v[0], v[1]}), b = gelu_pk((f32x2){v[2], v[3]}); return (f32x4){a.x, a.y, b.x, b.y}; }
__device__ __forceinline__ f32x4 sigm4(f32x4 v) { return (f32x4){sigm(v[0]), sigm(v[1]), sigm(v[2]), sigm(v[3])}; }
__device__ __forceinline__ u32x4 pack8(f32x4 v0, f32x4 v1) { u32x4 w; w.x = cvt_pk_bf16(v0[0], v0[1]); w.y = cvt_pk_bf16(v0[2], v0[3]); w.z = cvt_pk_bf16(v1[0], v1[1]); w.w = cvt_pk_bf16(v1[2], v1[3]); return w; }
__device__ __forceinline__ void unpack8(u32x4 w, f32x4& v0, f32x4& v1) { v0 = (f32x4){bflo(w.x), bfhi(w.x), bflo(w.y), bfhi(w.y)}; v1 = (f32x4){bflo(w.z), bfhi(w.z), bflo(w.w), bfhi(w.w)}; }
__device__ __forceinline__ float hsum4(f32x4 v) { return (v[0] + v[1]) + (v[2] + v[3]); }
__device__ __forceinline__ float hsq4(f32x4 v) { return (v[0] * v[0] + v[1] * v[1]) + (v[2] * v[2] + v[3] * v[3]); }
__device__ __forceinline__ float row_rstd(const float* stat, int row, int fq, float eps) {
    const f32x4* p = (const f32x4*)(stat + (size_t)row * 64 + fq * 16);
    const f32x4 a = p[0], b = p[1], c = p[2], d = p[3];
    float s = (hsum4(a) + hsum4(b)) + (hsum4(c) + hsum4(d));
    s += __shfl_xor(s, 16); s += __shfl_xor(s, 32);
    return rsqrtf(s * (1.0f / D_MODEL) + eps);
}

struct EpiProj {
    static constexpr bool PERM = true, HAS_MID = false;
    bf16_t* O; float* statv; unsigned* kn;
    __device__ __forceinline__ void mid(f32x4 (&)[2][2][4][2], const Unit&, int, int, int, int) const {}
    __device__ __forceinline__ void operator()(const f32x4 (&acc)[2][2][4][2], const Unit& u, int wr, int wc, int fr, int fq) const {
        const int t = u.pn >> 4, ct = u.pn & 15;
        const int row0 = u.pm * BM + wr * 64 + fr, col0 = ct * BM + wc * 32 + 8 * fq;
        bf16_t* base = O + (size_t)t * ((size_t)M_TOK * D_MODEL);
        if (t == 1) {
#pragma unroll
            for (int ai = 0; ai < 2; ++ai)
#pragma unroll
                for (int m = 0; m < 4; ++m) { const int row = row0 + ai * HALF + m * 16; bf16_t* rowp = base + (size_t)row * D_MODEL + col0; float s = 0.f, ss = 0.f;
#pragma unroll
                    for (int bj = 0; bj < 2; ++bj) { const f32x4 v0 = gelu4(acc[ai][bj][m][0]), v1 = gelu4(acc[ai][bj][m][1]);
                        s += hsum4(v0) + hsum4(v1); ss += hsq4(v0) + hsq4(v1);
                        *(u32x4*)(rowp + bj * HALF) = pack8(v0, v1); }
                    s += __shfl_xor(s, 16); s += __shfl_xor(s, 32); ss += __shfl_xor(ss, 16); ss += __shfl_xor(ss, 32);
                    if (fq == 0) *(f32x2*)(statv + ((size_t)row * 64 + ct * 4 + wc) * 2) = (f32x2){s, ss}; }
        } else {
            const float sc = (t == 2) ? QSCALE : 1.f;
            if (t == 3) {
                float mx0 = 0.f, mx1 = 0.f;
#pragma unroll
                for (int ai = 0; ai < 2; ++ai)
#pragma unroll
                    for (int m = 0; m < 4; ++m) { float s0 = hsq4(acc[ai][0][m][0]) + hsq4(acc[ai][0][m][1]), s1 = hsq4(acc[ai][1][m][0]) + hsq4(acc[ai][1][m][1]);
                        s0 += __shfl_xor(s0, 16); s0 += __shfl_xor(s0, 32); s1 += __shfl_xor(s1, 16); s1 += __shfl_xor(s1, 32); mx0 = fmaxf(mx0, s0); mx1 = fmaxf(mx1, s1); }
                mx0 = fmaxf(mx0, swz_xor<1>(mx0)); mx0 = fmaxf(mx0, swz_xor<2>(mx0)); mx0 = fmaxf(mx0, swz_xor<4>(mx0)); mx0 = fmaxf(mx0, swz_xor<8>(mx0));
                mx1 = fmaxf(mx1, swz_xor<1>(mx1)); mx1 = fmaxf(mx1, swz_xor<2>(mx1)); mx1 = fmaxf(mx1, swz_xor<4>(mx1)); mx1 = fmaxf(mx1, swz_xor<8>(mx1));
                if (fr == 0 && fq == 0) { unsigned* kp = kn + (((u.pm >> 5) * 16 + ct) * 2) * 4 + wc; atomicMax(kp, __float_as_uint(mx0)); atomicMax(kp + 4, __float_as_uint(mx1)); }
            }
#pragma unroll
            for (int ai = 0; ai < 2; ++ai)
#pragma unroll
                for (int m = 0; m < 4; ++m) { bf16_t* rowp = base + (size_t)(row0 + ai * HALF + m * 16) * D_MODEL + col0;
#pragma unroll
                    for (int bj = 0; bj < 2; ++bj) *(u32x4*)(rowp + bj * HALF) = pack8(acc[ai][bj][m][0] * sc, acc[ai][bj][m][1] * sc); }
        }
    }
};
struct EpiGates {
    static constexpr bool PERM = true, HAS_MID = false;
    bf16_t* O; const float* bgate;
    __device__ __forceinline__ void mid(f32x4 (&)[2][2][4][2], const Unit&, int, int, int, int) const {}
    __device__ __forceinline__ void operator()(const f32x4 (&acc)[2][2][4][2], const Unit& u, int wr, int wc, int fr, int fq) const {
        const int row0 = u.pm * BM + wr * 64 + fr, col0 = u.pn * HALF + wc * 32 + 8 * fq;
        bf16_t* RA = O + (size_t)5 * ((size_t)M_TOK * D_MODEL); bf16_t* SBo = O + (size_t)6 * ((size_t)M_TOK * D_MODEL);
        const f32x4 a0 = *(const f32x4*)(bgate + col0), a1 = *(const f32x4*)(bgate + col0 + 4), b0 = *(const f32x4*)(bgate + D_MODEL + col0), b1 = *(const f32x4*)(bgate + D_MODEL + col0 + 4);
#pragma unroll
        for (int ai = 0; ai < 2; ++ai)
#pragma unroll
            for (int m = 0; m < 4; ++m) { const size_t off = (size_t)(row0 + ai * HALF + m * 16) * D_MODEL + col0;
                f32x4 r0, r1, s0, s1;
#pragma unroll
                for (int j = 0; j < 4; ++j) {
                    const float ea0 = 1.f + __builtin_amdgcn_exp2f(-1.4426950408889634f * (acc[ai][0][m][0][j] * F8_DESC + a0[j])), ea1 = 1.f + __builtin_amdgcn_exp2f(-1.4426950408889634f * (acc[ai][0][m][1][j] * F8_DESC + a1[j]));
                    const float eb0 = 1.f + __builtin_amdgcn_exp2f(-1.4426950408889634f * (acc[ai][1][m][0][j] * F8_DESC + b0[j])), eb1 = 1.f + __builtin_amdgcn_exp2f(-1.4426950408889634f * (acc[ai][1][m][1][j] * F8_DESC + b1[j]));
                    r0[j] = eb0 * __builtin_amdgcn_rcpf(ea0); r1[j] = eb1 * __builtin_amdgcn_rcpf(ea1); s0[j] = __builtin_amdgcn_rcpf(eb0); s1[j] = __builtin_amdgcn_rcpf(eb1); }
                *(u32x4*)(RA + off) = pack8(r0, r1); *(u32x4*)(SBo + off) = pack8(s0, s1); }
    }
};
template <int MODE> struct EpiProbe {
    static constexpr bool PERM = true, HAS_MID = false;
    bf16_t* O;
    __device__ __forceinline__ void mid(f32x4 (&)[2][2][4][2], const Unit&, int, int, int, int) const {}
    __device__ __forceinline__ void operator()(const f32x4 (&acc)[2][2][4][2], const Unit& u, int wr, int wc, int fr, int fq) const {
        const int t = u.pn >> 4, ct = u.pn & 15;
        const int row0 = u.pm * BM + wr * 64 + fr, col0 = ct * BM + wc * 32 + 8 * fq;
        bf16_t* base = O + (size_t)t * ((size_t)M_TOK * D_MODEL);
#pragma unroll
        for (int ai = 0; ai < 2; ++ai)
#pragma unroll
            for (int m = 0; m < 4; ++m) { bf16_t* rowp = base + (size_t)(row0 + ai * HALF + m * 16) * D_MODEL + col0;
#pragma unroll
                for (int bj = 0; bj < 2; ++bj) { if (MODE == 1) *(u32x4*)(rowp + bj * HALF) = pack8(acc[ai][bj][m][0], acc[ai][bj][m][1]);
                    else asm volatile("" :: "v"(acc[ai][bj][m][0]), "v"(acc[ai][bj][m][1])); } }
    }
};
struct EpiNull {
    static constexpr bool PERM = true, HAS_MID = false;
    __device__ __forceinline__ void mid(f32x4 (&)[2][2][4][2], const Unit&, int, int, int, int) const {}
    __device__ __forceinline__ void operator()(const f32x4 (&acc)[2][2][4][2], const Unit&, int, int, int, int) const {
#pragma unroll
        for (int ai = 0; ai < 2; ++ai)
#pragma unroll
            for (int m = 0; m < 4; ++m)
#pragma unroll
                for (int bj = 0; bj < 2; ++bj) asm volatile("" :: "v"(acc[ai][bj][m][0]), "v"(acc[ai][bj][m][1]));
    }
};
struct EpiPlain {
    static constexpr bool PERM = true, HAS_MID = false;
    bf16_t* O; int ldc;
    __device__ __forceinline__ void mid(f32x4 (&)[2][2][4][2], const Unit&, int, int, int, int) const {}
    __device__ __forceinline__ void operator()(const f32x4 (&acc)[2][2][4][2], const Unit& u, int wr, int wc, int fr, int fq) const {
        const int row0 = u.pm * BM + wr * 64 + fr, col0 = u.pn * BM + wc * 32 + 8 * fq;
#pragma unroll
        for (int ai = 0; ai < 2; ++ai)
#pragma unroll
            for (int m = 0; m < 4; ++m) { bf16_t* rowp = O + (size_t)(row0 + ai * HALF + m * 16) * ldc + col0;
#pragma unroll
                for (int bj = 0; bj < 2; ++bj) *(u32x4*)(rowp + bj * HALF) = pack8(acc[ai][bj][m][0], acc[ai][bj][m][1]); }
    }
};
struct EpiMerge {
    static constexpr bool PERM = true, HAS_MID = true;
    const bf16_t* RA; const bf16_t* SB; bf16_t* O;
    __device__ __forceinline__ void mid(f32x4 (&acc)[2][2][4][2], const Unit& u, int wr, int wc, int fr, int fq) const {
        const int row0 = u.pm * BM + wr * 64 + fr, col0 = u.pn * BM + wc * 32 + 8 * fq;
        u32x4 w[2][4][2];
#pragma unroll
        for (int ai = 0; ai < 2; ++ai)
#pragma unroll
            for (int m = 0; m < 4; ++m)
#pragma unroll
                for (int bj = 0; bj < 2; ++bj) w[ai][m][bj] = *(const u32x4*)(RA + (size_t)(row0 + ai * HALF + m * 16) * D_MODEL + col0 + bj * HALF);
#pragma unroll
        for (int ai = 0; ai < 2; ++ai)
#pragma unroll
            for (int m = 0; m < 4; ++m)
#pragma unroll
                for (int bj = 0; bj < 2; ++bj) { f32x4 a0, a1; unpack8(w[ai][m][bj], a0, a1); acc[ai][bj][m][0] *= a0; acc[ai][bj][m][1] *= a1; }
        asm volatile("" ::: "memory");
    }
    __device__ __forceinline__ void operator()(const f32x4 (&acc)[2][2][4][2], const Unit& u, int wr, int wc, int fr, int fq) const {
        const int row0 = u.pm * BM + wr * 64 + fr, col0 = u.pn * BM + wc * 32 + 8 * fq;
        u32x4 w[2][4][2];
#pragma unroll
        for (int ai = 0; ai < 2; ++ai)
#pragma unroll
            for (int m = 0; m < 4; ++m)
#pragma unroll
                for (int bj = 0; bj < 2; ++bj) w[ai][m][bj] = *(const u32x4*)(SB + (size_t)(row0 + ai * HALF + m * 16) * D_MODEL + col0 + bj * HALF);
#pragma unroll
        for (int ai = 0; ai < 2; ++ai) {
#pragma unroll
            for (int m = 0; m < 4; ++m)
#pragma unroll
                for (int bj = 0; bj < 2; ++bj) { f32x4 b0, b1; unpack8(w[ai][m][bj], b0, b1);
                    *(u32x4*)(O + (size_t)(row0 + ai * HALF + m * 16) * D_MODEL + col0 + bj * HALF) = pack8(acc[ai][bj][m][0] * b0, acc[ai][bj][m][1] * b1); }
            asm volatile("" ::: "memory"); }
    }
};
struct EpiResF32 {
    static constexpr bool PERM = true, HAS_MID = false;
    const float* res; bf16_t* XB; float* stat;
    __device__ __forceinline__ void mid(f32x4 (&)[2][2][4][2], const Unit&, int, int, int, int) const {}
    __device__ __forceinline__ void operator()(const f32x4 (&acc)[2][2][4][2], const Unit& u, int wr, int wc, int fr, int fq) const {
        const int row0 = u.pm * BM + wr * 64 + fr, col0 = u.pn * BM + wc * 32 + 8 * fq;
#pragma unroll
        for (int ai = 0; ai < 2; ++ai) { f32x4 r[4][2][2];
#pragma unroll
            for (int m = 0; m < 4; ++m)
#pragma unroll
                for (int bj = 0; bj < 2; ++bj) { const float* p = res + (size_t)(row0 + ai * HALF + m * 16) * D_MODEL + col0 + bj * HALF; r[m][bj][0] = *(const f32x4*)p; r[m][bj][1] = *(const f32x4*)(p + 4); }
#pragma unroll
            for (int m = 0; m < 4; ++m) { const int row = row0 + ai * HALF + m * 16; const size_t off = (size_t)row * D_MODEL + col0; float ss = 0.f;
#pragma unroll
                for (int bj = 0; bj < 2; ++bj) { const f32x4 v0 = r[m][bj][0] + acc[ai][bj][m][0], v1 = r[m][bj][1] + acc[ai][bj][m][1];
                    ss += hsq4(v0) + hsq4(v1); *(u32x4*)(XB + off + bj * HALF) = pack8(v0, v1); }
                ss += __shfl_xor(ss, 16); ss += __shfl_xor(ss, 32);
                if (fq == 0) stat[(size_t)row * 64 + u.pn * 4 + wc] = ss; }
            asm volatile("" ::: "memory"); }
    }
};
struct EpiResBf {
    static constexpr bool PERM = true, HAS_MID = false;
    bf16_t* XB; float* stat; bf16_t* XO; unsigned char* X8;
    __device__ __forceinline__ void mid(f32x4 (&)[2][2][4][2], const Unit&, int, int, int, int) const {}
    __device__ __forceinline__ void operator()(const f32x4 (&acc)[2][2][4][2], const Unit& u, int wr, int wc, int fr, int fq) const {
        const int row0 = u.pm * BM + wr * 64 + fr, col0 = u.pn * BM + wc * 32 + 8 * fq;
        u32x4 w[2][4][2];
#pragma unroll
        for (int ai = 0; ai < 2; ++ai)
#pragma unroll
            for (int m = 0; m < 4; ++m)
#pragma unroll
                for (int bj = 0; bj < 2; ++bj) w[ai][m][bj] = *(const u32x4*)(XB + (size_t)(row0 + ai * HALF + m * 16) * D_MODEL + col0 + bj * HALF);
#pragma unroll
        for (int ai = 0; ai < 2; ++ai) {
#pragma unroll
            for (int m = 0; m < 4; ++m) { const int row = row0 + ai * HALF + m * 16; const size_t off = (size_t)row * D_MODEL + col0; float ss = 0.f;
#pragma unroll
                for (int bj = 0; bj < 2; ++bj) { f32x4 r0, r1; unpack8(w[ai][m][bj], r0, r1); const f32x4 v0 = r0 + acc[ai][bj][m][0], v1 = r1 + acc[ai][bj][m][1];
                    ss += hsq4(v0) + hsq4(v1); *(u32x4*)(XO + off + bj * HALF) = pack8(v0, v1);
                    const f32x4 s0 = v0 * F8_SA, s1 = v1 * F8_SA; *(u32x2*)(X8 + off + bj * HALF) = (u32x2){pk_fp8x4(s0[0], s0[1], s0[2], s0[3]), pk_fp8x4(s1[0], s1[1], s1[2], s1[3])}; }
                ss += __shfl_xor(ss, 16); ss += __shfl_xor(ss, 32);
                if (fq == 0) stat[(size_t)row * 64 + u.pn * 4 + wc] = ss; }
            asm volatile("" ::: "memory"); }
    }
};
struct RowScale { const LAS float* rs_lds; int rs_pm; const float* stat;
    __device__ __forceinline__ float get(const Unit& u, int rt, int row, int fq) const { return (u.pm == rs_pm) ? rs_lds[rt] : row_rstd(stat, row, fq, RMS_EPS); } };
struct EpiSwiglu {
    static constexpr bool PERM = true, HAS_MID = false;
    RowScale rsc; bf16_t* O;
    __device__ __forceinline__ void mid(f32x4 (&)[2][2][4][2], const Unit&, int, int, int, int) const {}
    __device__ __forceinline__ void operator()(const f32x4 (&acc)[2][2][4][2], const Unit& u, int wr, int wc, int fr, int fq) const {
        const int rt0 = wr * 64 + fr, row0 = u.pm * BM + rt0, col0 = u.pn * HALF + wc * 32 + 8 * fq;
#pragma unroll
        for (int ai = 0; ai < 2; ++ai)
#pragma unroll
            for (int m = 0; m < 4; ++m) { const int row = row0 + ai * HALF + m * 16; const float rs = rsc.get(u, rt0 + ai * HALF + m * 16, row, fq);
                f32x4 h0, h1;
#pragma unroll
                for (int j = 0; j < 4; ++j) { const float g0 = acc[ai][0][m][0][j] * rs, g1 = acc[ai][0][m][1][j] * rs;
                    h0[j] = g0 * sigm(g0) * (acc[ai][1][m][0][j] * rs); h1[j] = g1 * sigm(g1) * (acc[ai][1][m][1][j] * rs); }
                *(u32x4*)(O + (size_t)row * D_FF + col0) = pack8(h0, h1); }
    }
};
struct EpiPle {
    static constexpr bool PERM = true, HAS_MID = false;
    RowScale rsc; const bf16_t* XB2; const bf16_t* PP; bf16_t* X3; float* stat3;
    __device__ __forceinline__ void mid(f32x4 (&)[2][2][4][2], const Unit&, int, int, int, int) const {}
    __device__ __forceinline__ void operator()(const f32x4 (&acc)[2][2][4][2], const Unit& u, int wr, int wc, int fr, int fq) const {
        const int rt0 = wr * 64 + fr, row0 = u.pm * BM + rt0, col0 = u.pn * BM + wc * 32 + 8 * fq;
#pragma unroll
        for (int ai = 0; ai < 2; ++ai) { u32x4 wx[4][2], wp[4][2];
#pragma unroll
            for (int m = 0; m < 4; ++m)
#pragma unroll
                for (int bj = 0; bj < 2; ++bj) { const size_t off = (size_t)(row0 + ai * HALF + m * 16) * D_MODEL + col0 + bj * HALF; wx[m][bj] = *(const u32x4*)(XB2 + off); wp[m][bj] = *(const u32x4*)(PP + off); }
#pragma unroll
            for (int m = 0; m < 4; ++m) { const int row = row0 + ai * HALF + m * 16; const size_t off = (size_t)row * D_MODEL + col0; float ss = 0.f;
                const float rs = rsc.get(u, rt0 + ai * HALF + m * 16, row, fq) * F8_DESC;
#pragma unroll
                for (int bj = 0; bj < 2; ++bj) { f32x4 r0, r1, p0, p1; unpack8(wx[m][bj], r0, r1); unpack8(wp[m][bj], p0, p1);
                    const f32x4 v0 = r0 + sigm4(acc[ai][bj][m][0] * rs) * p0, v1 = r1 + sigm4(acc[ai][bj][m][1] * rs) * p1;
                    ss += hsq4(v0) + hsq4(v1); *(u32x4*)(X3 + off + bj * HALF) = pack8(v0, v1); }
                ss += __shfl_xor(ss, 16); ss += __shfl_xor(ss, 32);
                if (fq == 0) stat3[(size_t)row * 64 + u.pn * 4 + wc] = ss; }
            asm volatile("" ::: "memory"); }
    }
};

__device__ __forceinline__ i32x8 cat8(bf16x8 a, bf16x8 b) { const i32x4 x = __builtin_bit_cast(i32x4, a), y = __builtin_bit_cast(i32x4, b); return __builtin_shufflevector(x, y, 0, 1, 2, 3, 4, 5, 6, 7); }
__device__ __forceinline__ void mfma_f8(f32x4& acc, i32x8 a, i32x8 b) { asm volatile("v_mfma_f32_16x16x128_f8f6f4 %0, %1, %2, %0" : "+v"(acc) : "v"(a), "v"(b)); }
template <class Epi, class Sched, bool ALIGN_EPI, bool SP2, bool F8 = false>
__device__ __forceinline__ void gemm_phase(LAS unsigned char* lds, const Gemm g, const Sched& S, const Epi& E, const int wid) {
    int lane = lane_id(); asm volatile("" : "+v"(lane));
    const int tid = wid * 64 + lane, wr = wid >> 2, wc = wid & 3, fr = lane & 15, fq = lane >> 4;
    int nt = g.K / BK, nt1 = g.nt1; asm volatile("" : "+s"(nt), "+s"(nt1));
    const int ld = g.ld;
    unsigned voffA[2], voffB[2];
#pragma unroll
    for (int i = 0; i < 2; ++i) { int R, C; stage_rc(tid * 16 + i * 8192, R, C); const int Rb = Epi::PERM ? ((R & ~31) + perm32(R & 31)) : R;
        voffA[i] = (unsigned)(R * ld + C) * 2u; voffB[i] = (unsigned)(Rb * ld + C) * 2u; }
    const size_t kstep = (size_t)(BK * 2);
    const size_t hstep = (size_t)HALF * ld * 2;
    const size_t tstep = 2 * hstep;
    const size_t seg2 = (size_t)nt1 * kstep;
    const unsigned ldsw = (unsigned)wid * 1024u;
    const int aoff = lds_byte(wr * 64 + fr, fq * 8), boff = lds_byte(wc * 32 + fr, fq * 8);
#define PG8_SA(b, h) (((b) * 2 + (h)) * HTB)
#define PG8_SB(b, h) ((4 + (b) * 2 + (h)) * HTB)
#define PG8_STAGE(bufoff, gbase, voff) do { _Pragma("unroll") for (int _i = 0; _i < 2; ++_i) \
        __builtin_amdgcn_global_load_lds((const unsigned*)((const char*)(gbase) + (voff)[_i]), (LAS unsigned*)(lds + (bufoff) + ldsw + _i * 8192), 16, 0, 0); } while (0)
#define PG8_LDA(dst, b, h) do { _Pragma("unroll") for (int m = 0; m < 4; ++m) _Pragma("unroll") for (int k = 0; k < 2; ++k) dst[m][k] = *(const LAS bf16x8*)(lds + PG8_SA(b, h) + aoff + m * 2048 + k * 1024); } while (0)
#define PG8_LDB(dst, b, h) do { _Pragma("unroll") for (int n = 0; n < 2; ++n) _Pragma("unroll") for (int k = 0; k < 2; ++k) dst[n][k] = *(const LAS bf16x8*)(lds + PG8_SB(b, h) + boff + n * 2048 + k * 1024); } while (0)
#define PG8_MMA(ai, bj, At, Bt) do { __builtin_amdgcn_s_setprio(1); \
        if constexpr (F8) { _Pragma("unroll") for (int m = 0; m < 4; ++m) _Pragma("unroll") for (int n = 0; n < 2; ++n) \
            mfma_f8(acc[ai][bj][m][n], cat8(Bt[n][0], Bt[n][1]), cat8(At[m][0], At[m][1])); } \
        else { _Pragma("unroll") for (int m = 0; m < 4; ++m) _Pragma("unroll") for (int n = 0; n < 2; ++n) _Pragma("unroll") for (int k = 0; k < 2; ++k) \
            acc[ai][bj][m][n] = __builtin_amdgcn_mfma_f32_16x16x32_bf16(Bt[n][k], At[m][k], acc[ai][bj][m][n], 0, 0, 0); } \
        __builtin_amdgcn_s_setprio(0); } while (0)
#define PG8_WAIT_V(n) asm volatile("s_waitcnt vmcnt(" #n ")" ::: "memory")
#define PG8_WAIT_L(n) asm volatile("s_waitcnt lgkmcnt(" #n ")" ::: "memory")
#define PG8_BAR __builtin_amdgcn_s_barrier()
#define PG8_SCHED __builtin_amdgcn_sched_barrier(0)
    Unit cur, nxt; int ui = 0;
    if (!S.next(0, cur)) return;
    f32x4 acc[2][2][4][2];
#pragma unroll
    for (int a = 0; a < 2; ++a)
#pragma unroll
        for (int b = 0; b < 2; ++b)
#pragma unroll
            for (int m = 0; m < 4; ++m)
#pragma unroll
                for (int n = 0; n < 2; ++n) acc[a][b][m][n] = (f32x4){0.f, 0.f, 0.f, 0.f};
    bf16x8 At[4][2], B0[2][2], B1[2][2];
    const char* cA = (const char*)g.A + (size_t)cur.pm * tstep; const char* cB = (const char*)g.Bt + (size_t)cur.pn * tstep;
    const char* cA2 = (const char*)g.A2 + (size_t)cur.pm * tstep - seg2; const char* cB2 = (const char*)g.Bt2 + (size_t)cur.pn * tstep - seg2;
    if constexpr (SP2) {
        PG8_STAGE(PG8_SB(0, 0), cB, voffB); PG8_STAGE(PG8_SB(0, 1), cB + hstep, voffB); PG8_STAGE(PG8_SA(0, 0), cA, voffA); PG8_STAGE(PG8_SA(0, 1), cA + hstep, voffA);
        if (wr == 1) PG8_BAR;
        PG8_WAIT_V(2); PG8_BAR;
        PG8_STAGE(PG8_SB(1, 0), cB + kstep, voffB); PG8_STAGE(PG8_SA(1, 0), cA + kstep, voffA); PG8_STAGE(PG8_SB(1, 1), cB + hstep + kstep, voffB);
        PG8_WAIT_V(6); PG8_BAR;
    } else {
        PG8_STAGE(PG8_SB(0, 0), cB, voffB); PG8_STAGE(PG8_SA(0, 0), cA, voffA); PG8_STAGE(PG8_SB(0, 1), cB + hstep, voffB); PG8_STAGE(PG8_SA(0, 1), cA + hstep, voffA);
        if (wr == 1) PG8_BAR;
        PG8_WAIT_V(4); PG8_BAR;
        PG8_STAGE(PG8_SB(1, 0), cB + kstep, voffB); PG8_STAGE(PG8_SA(1, 0), cA + kstep, voffA); PG8_STAGE(PG8_SB(1, 1), cB + hstep + kstep, voffB);
        PG8_WAIT_V(6); PG8_BAR;
    }
    for (;;) {
        const bool has_next = S.next(ui + 1, nxt);
        const char* nA = has_next ? (const char*)g.A + (size_t)nxt.pm * tstep : cA; const char* nB = has_next ? (const char*)g.Bt + (size_t)nxt.pn * tstep : cB;
        for (int t = 0; t < nt; t += 2) {
            const bool last = (t == nt - 2);
            const char* a1 = ((t + 1 < nt1) ? cA : cA2) + (size_t)(t + 1) * kstep;
            const bool s1 = (t + 2 < nt1);
            const char* a2 = last ? nA : (s1 ? cA : cA2) + (size_t)(t + 2) * kstep; const char* b2 = last ? nB : (s1 ? cB : cB2) + (size_t)(t + 2) * kstep;
            const char* a3 = a2 + kstep; const char* b3 = b2 + kstep;
            if constexpr (Epi::HAS_MID) { if (t == nt1) { int l2 = lane; asm volatile("" : "+v"(l2)); E.mid(acc, cur, wr, wc, l2 & 15, l2 >> 4); } }
            if constexpr (SP2) {
            PG8_LDB(B0, 0, 0); PG8_LDB(B1, 0, 1); PG8_SCHED; PG8_LDA(At, 0, 0); PG8_STAGE(PG8_SA(1, 1), a1 + hstep, voffA);
            PG8_WAIT_V(8); PG8_WAIT_L(0); PG8_BAR; PG8_MMA(0, 0, At, B0); PG8_MMA(0, 1, At, B1); PG8_BAR; PG8_SCHED;
            PG8_LDA(At, 0, 1); PG8_STAGE(PG8_SB(0, 0), b2, voffB); PG8_STAGE(PG8_SB(0, 1), b2 + hstep, voffB); PG8_STAGE(PG8_SA(0, 0), a2, voffA);
            PG8_WAIT_V(8); PG8_WAIT_L(0); PG8_BAR; PG8_MMA(1, 0, At, B0); PG8_MMA(1, 1, At, B1); PG8_BAR; PG8_SCHED;
            PG8_LDB(B0, 1, 0); PG8_LDB(B1, 1, 1); PG8_SCHED; PG8_LDA(At, 1, 0); PG8_STAGE(PG8_SA(0, 1), a2 + hstep, voffA);
            PG8_WAIT_V(8); PG8_WAIT_L(0); PG8_BAR; PG8_MMA(0, 0, At, B0); PG8_MMA(0, 1, At, B1); PG8_BAR; PG8_SCHED;
            PG8_LDA(At, 1, 1); PG8_STAGE(PG8_SB(1, 0), b3, voffB); PG8_STAGE(PG8_SB(1, 1), b3 + hstep, voffB); PG8_STAGE(PG8_SA(1, 0), a3, voffA);
            PG8_WAIT_V(8); PG8_WAIT_L(0); PG8_BAR; PG8_MMA(1, 0, At, B0); PG8_MMA(1, 1, At, B1); PG8_BAR; PG8_SCHED;
            } else {
            PG8_LDB(B0, 0, 0); PG8_SCHED; PG8_LDA(At, 0, 0); PG8_STAGE(PG8_SA(1, 1), a1 + hstep, voffA);
            PG8_WAIT_L(8); PG8_BAR; PG8_WAIT_L(0); PG8_MMA(0, 0, At, B0); PG8_BAR; PG8_SCHED;
            PG8_LDB(B1, 0, 1); PG8_STAGE(PG8_SB(0, 0), b2, voffB);
            PG8_BAR; PG8_WAIT_L(0); PG8_MMA(0, 1, At, B1); PG8_BAR;
            PG8_LDA(At, 0, 1); PG8_STAGE(PG8_SA(0, 0), a2, voffA);
            PG8_BAR; PG8_WAIT_L(0); PG8_MMA(1, 0, At, B0); PG8_BAR; PG8_SCHED;
            PG8_STAGE(PG8_SB(0, 1), b2 + hstep, voffB);
            PG8_WAIT_V(6); PG8_BAR; PG8_MMA(1, 1, At, B1); PG8_BAR;
            PG8_LDB(B0, 1, 0); PG8_SCHED; PG8_LDA(At, 1, 0); PG8_STAGE(PG8_SA(0, 1), a2 + hstep, voffA);
            PG8_WAIT_L(8); PG8_BAR; PG8_WAIT_L(0); PG8_MMA(0, 0, At, B0); PG8_BAR; PG8_SCHED;
            PG8_LDB(B1, 1, 1); PG8_STAGE(PG8_SB(1, 0), b3, voffB);
            PG8_BAR; PG8_WAIT_L(0); PG8_MMA(0, 1, At, B1); PG8_BAR;
            PG8_LDA(At, 1, 1); PG8_STAGE(PG8_SA(1, 0), a3, voffA);
            PG8_BAR; PG8_WAIT_L(0); PG8_MMA(1, 0, At, B0); PG8_BAR; PG8_SCHED;
            PG8_STAGE(PG8_SB(1, 1), b3 + hstep, voffB);
            PG8_WAIT_V(6); PG8_BAR; PG8_MMA(1, 1, At, B1); PG8_BAR;
            }
        }
        if constexpr (ALIGN_EPI) { if (wr == 0) PG8_BAR; }
        if constexpr (F8) asm volatile("s_nop 15\n\ts_nop 15" ::: "memory");
        { int l2 = lane; asm volatile("" : "+v"(l2)); E(acc, cur, wr, wc, l2 & 15, l2 >> 4); }
        if (!has_next) break;
#pragma unroll
        for (int a = 0; a < 2; ++a)
#pragma unroll
            for (int b = 0; b < 2; ++b)
#pragma unroll
                for (int m = 0; m < 4; ++m)
#pragma unroll
                    for (int n = 0; n < 2; ++n) acc[a][b][m][n] = (f32x4){0.f, 0.f, 0.f, 0.f};
        cur = nxt; cA = nA; cB = nB; ++ui;
        cA2 = (const char*)g.A2 + (size_t)cur.pm * tstep - seg2; cB2 = (const char*)g.Bt2 + (size_t)cur.pn * tstep - seg2;
        if constexpr (ALIGN_EPI) { if (wr == 1) PG8_BAR; }
    }
    PG8_WAIT_V(0);
    if constexpr (!ALIGN_EPI) { if (wr == 0) PG8_BAR; }
    PG8_BAR;
#undef PG8_SA
#undef PG8_SB
#undef PG8_STAGE
#undef PG8_LDA
#undef PG8_LDB
#undef PG8_MMA
#undef PG8_WAIT_V
#undef PG8_WAIT_L
#undef PG8_BAR
#undef PG8_SCHED
}
}

__device__ const unsigned short ATT_ITEMS[3208] = {767,1983,2048,765,1981,2056,763,1979,2064,761,1977,2072,698,2080,700,702,2088,696,759,2096,1975,694,2104,757,2112,1973,692,2120,755,1971,2128,690,753,2136,1969,2144,688,751,2152,1967,686,2160,749,1965,2168,684,747,2176,1963,2184,682,745,2192,1961,680,2200,743,1959,2208,678,2216,741,1957,2224,676,739,2232,1955,674,2240,737,2248,1953,672,2256,735,1951,2264,670,733,2272,1949,2280,542,544,2288,546,548,2296,550,552,2304,554,556,2312,558,2320,560,562,2328,564,566,2336,568,570,2344,572,2352,574,540,2360,668,731,2368,1947,538,2376,666,2384,729,1945,2392,536,664,2400,727,1943,2408,534,2416,662,725,2424,1941,469,2432,471,473,2440,475,477,2448,479,2456,481,483,2464,485,487,2472,489,491,2480,493,2488,495,497,2496,499,501,2504,503,505,2512,507,2520,509,511,2528,532,660,2536,467,723,2544,1939,2552,530,658,2560,465,721,2568,1937,528,2576,656,463,2584,719,2592,1935,526,2600,654,461,2608,717,1933,2616,524,2624,652,459,2632,715,1931,2640,331,333,2648,335,2656,337,339,2664,341,343,2672,345,347,2680,349,351,2688,353,2696,355,357,2704,359,361,2712,363,365,2720,367,2728,369,371,2736,373,375,2744,377,379,2752,381,2760,383,522,2768,650,329,2776,457,713,2784,1929,2792,520,648,2800,327,455,2808,711,1927,2816,518,646,2824,325,2832,453,709,2840,1925,132,2848,134,136,2856,138,2864,140,142,2872,144,146,2880,148,150,2888,152,2896,154,156,2904,158,160,2912,162,164,2920,166,2928,168,170,2936,172,174,2944,176,178,2952,180,182,2960,184,2968,186,188,2976,190,516,2984,644,323,2992,451,3000,707,1923,3008,2,4,3016,6,8,3024,10,3032,12,14,3040,16,18,3048,20,22,3056,24,3064,26,28,3072,30,32,3080,34,36,3088,38,40,3096,42,3104,44,46,3112,48,50,3120,52,54,3128,56,3136,58,60,3144,62,130,3152,514,642,3160,321,3168,449,705,3176,1921,0,3184,128,512,3192,640,3200,831,2047,2049,829,2045,2057,827,2043,2065,825,2041,2073,1722,2081,1724,1726,2089,1720,823,2097,2039,1718,2105,821,2113,2037,1716,2121,819,2035,2129,1714,817,2137,2033,2145,1712,815,2153,2031,1710,2161,813,2029,2169,1708,811,2177,2027,2185,1706,809,2193,2025,1704,2201,807,2023,2209,1702,2217,805,2021,2225,1700,803,2233,2019,1698,2241,801,2249,2017,1696,2257,799,2015,2265,1694,797,2273,2013,2281,1566,1568,2289,1570,1572,2297,1574,1576,2305,1578,1580,2313,1582,2321,1584,1586,2329,1588,1590,2337,1592,1594,2345,1596,2353,1598,1564,2361,1692,795,2369,2011,1562,2377,1690,2385,793,2009,2393,1560,1688,2401,791,2007,2409,1558,2417,1686,789,2425,2005,1493,2433,1495,1497,2441,1499,1501,2449,1503,2457,1505,1507,2465,1509,1511,2473,1513,1515,2481,1517,2489,1519,1521,2497,1523,1525,2505,1527,1529,2513,1531,2521,1533,1535,2529,1556,1684,2537,787,1491,2545,2003,2553,1554,1682,2561,785,1489,2569,2001,1552,2577,1680,783,2585,1487,2593,1999,1550,2601,1678,781,2609,1485,1997,2617,1548,2625,1676,779,2633,1483,1995,2641,1355,1357,2649,1359,2657,1361,1363,2665,1365,1367,2673,1369,1371,2681,1373,1375,2689,1377,2697,1379,1381,2705,1383,1385,2713,1387,1389,2721,1391,2729,1393,1395,2737,1397,1399,2745,1401,1403,2753,1405,2761,1407,1546,2769,1674,777,2777,1353,1481,2785,1993,2793,1544,1672,2801,775,1351,2809,1479,1991,2817,1542,1670,2825,773,2833,1349,1477,2841,1989,1156,2849,1158,1160,2857,1162,2865,1164,1166,2873,1168,1170,2881,1172,1174,2889,1176,2897,1178,1180,2905,1182,1184,2913,1186,1188,2921,1190,2929,1192,1194,2937,1196,1198,2945,1200,1202,2953,1204,1206,2961,1208,2969,1210,1212,2977,1214,1540,2985,1668,771,2993,1347,3001,1475,1987,3009,1026,1028,3017,1030,1032,3025,1034,3033,1036,1038,3041,1040,1042,3049,1044,1046,3057,1048,3065,1050,1052,3073,1054,1056,3081,1058,1060,3089,1062,1064,3097,1066,3105,1068,1070,3113,1072,1074,3121,1076,1078,3129,1080,3137,1082,1084,3145,1086,1154,3153,1538,1666,3161,769,3169,1345,1473,3177,1985,1024,3185,1152,1536,3193,1664,3201,895,1982,2050,893,1980,2058,891,1978,2066,889,697,2074,699,2082,701,703,2090,1976,695,2098,887,1974,2106,693,2114,885,1972,2122,691,883,2130,1970,689,2138,881,2146,1968,687,2154,879,1966,2162,685,877,2170,1964,683,2178,875,2186,1962,681,2194,873,1960,2202,679,871,2210,1958,2218,677,869,2226,1956,675,2234,867,1954,2242,673,2250,865,1952,2258,671,863,2266,1950,669,2274,861,2282,541,543,2290,545,547,2298,549,551,2306,553,555,2314,557,2322,559,561,2330,563,565,2338,567,569,2346,571,2354,573,575,2362,1948,539,2370,667,859,2378,1946,2386,537,665,2394,857,1944,2402,535,663,2410,855,2418,1942,533,2426,661,853,2434,468,470,2442,472,474,2450,476,2458,478,480,2466,482,484,2474,486,488,2482,490,2490,492,494,2498,496,498,2506,500,502,2514,504,2522,506,508,2530,510,1940,2538,531,659,2546,851,2554,466,1938,2562,529,657,2570,849,464,2578,1936,527,2586,655,2594,847,462,2602,1934,525,2610,653,845,2618,460,2626,1932,523,2634,651,843,2642,330,332,2650,334,2658,336,338,2666,340,342,2674,344,346,2682,348,350,2690,352,2698,354,356,2706,358,360,2714,362,364,2722,366,2730,368,370,2738,372,374,2746,376,378,2754,380,2762,382,458,2770,1930,521,2778,649,841,2786,328,2794,456,1928,2802,519,647,2810,839,326,2818,454,1926,2826,517,2834,645,837,2842,133,135,2850,137,139,2858,141,2866,143,145,2874,147,149,2882,151,153,2890,155,2898,157,159,2906,161,163,2914,165,167,2922,169,2930,171,173,2938,175,177,2946,179,181,2954,183,185,2962,187,2970,189,191,2978,324,452,2986,1924,131,2994,515,3002,643,835,3010,3,5,3018,7,9,3026,11,3034,13,15,3042,17,19,3050,21,23,3058,25,3066,27,29,3074,31,33,3082,35,37,3090,39,41,3098,43,3106,45,47,3114,49,51,3122,53,55,3130,57,3138,59,61,3146,63,322,3154,450,1922,3162,1,3170,129,513,3178,641,833,3186,320,448,3194,1920,3202,959,2046,2051,957,2044,2059,955,2042,2067,953,1721,2075,1723,2083,1725,1727,2091,2040,951,2099,1719,2038,2107,949,2115,1717,2036,2123,947,1715,2131,2034,945,2139,1713,2147,2032,943,2155,1711,2030,2163,941,1709,2171,2028,939,2179,1707,2187,2026,937,2195,1705,2024,2203,935,1703,2211,2022,2219,933,1701,2227,2020,931,2235,1699,2018,2243,929,2251,1697,2016,2259,927,1695,2267,2014,925,2275,1693,2283,1565,1567,2291,1569,1571,2299,1573,1575,2307,1577,1579,2315,1581,2323,1583,1585,2331,1587,1589,2339,1591,1593,2347,1595,2355,1597,1599,2363,2012,923,2371,1563,1691,2379,2010,2387,921,1561,2395,1689,2008,2403,919,1559,2411,1687,2419,2006,917,2427,1557,1685,2435,1492,1494,2443,1496,1498,2451,1500,2459,1502,1504,2467,1506,1508,2475,1510,1512,2483,1514,2491,1516,1518,2499,1520,1522,2507,1524,1526,2515,1528,2523,1530,1532,2531,1534,2004,2539,915,1555,2547,1683,2555,1490,2002,2563,913,1553,2571,1681,1488,2579,2000,911,2587,1551,2595,1679,1486,2603,1998,909,2611,1549,1677,2619,1484,2627,1996,907,2635,1547,1675,2643,1354,1356,2651,1358,2659,1360,1362,2667,1364,1366,2675,1368,1370,2683,1372,1374,2691,1376,2699,1378,1380,2707,1382,1384,2715,1386,1388,2723,1390,2731,1392,1394,2739,1396,1398,2747,1400,1402,2755,1404,2763,1406,1482,2771,1994,905,2779,1545,1673,2787,1352,2795,1480,1992,2803,903,1543,2811,1671,1350,2819,1478,1990,2827,901,2835,1541,1669,2843,1157,1159,2851,1161,1163,2859,1165,2867,1167,1169,2875,1171,1173,2883,1175,1177,2891,1179,2899,1181,1183,2907,1185,1187,2915,1189,1191,2923,1193,2931,1195,1197,2939,1199,1201,2947,1203,1205,2955,1207,1209,2963,1211,2971,1213,1215,2979,1348,1476,2987,1988,899,2995,1155,3003,1539,1667,3011,1027,1029,3019,1031,1033,3027,1035,3035,1037,1039,3043,1041,1043,3051,1045,1047,3059,1049,3067,1051,1053,3075,1055,1057,3083,1059,1061,3091,1063,1065,3099,1067,3107,1069,1071,3115,1073,1075,3123,1077,1079,3131,1081,3139,1083,1085,3147,1087,1346,3155,1474,1986,3163,897,3171,1025,1153,3179,1537,1665,3187,1344,1472,3195,1984,3203,1023,766,2052,1022,1021,2060,764,1020,2068,1019,762,2076,1018,2084,1017,760,2092,1016,1015,2100,758,1014,2108,1013,2116,756,1012,2124,1011,754,2132,1010,1009,2140,752,2148,1008,1007,2156,750,1006,2164,1005,748,2172,1004,1003,2180,746,2188,1002,1001,2196,617,619,2204,621,623,2212,625,2220,627,629,2228,631,633,2236,635,637,2244,639,2252,744,1000,2260,615,999,2268,742,998,2276,613,2284,997,740,2292,996,611,2300,995,738,2308,994,609,2316,993,2324,736,992,2332,607,991,2340,734,990,2348,605,2356,989,732,2364,988,603,2372,987,730,2380,986,2388,601,985,2396,728,984,2404,599,983,2412,726,2420,982,597,2428,981,724,2436,980,595,2444,979,722,2452,978,2460,593,977,2468,720,976,2476,591,975,2484,400,2492,402,404,2500,406,408,2508,410,412,2516,414,2524,416,418,2532,420,422,2540,424,426,2548,428,2556,430,432,2564,434,436,2572,438,440,2580,442,444,2588,446,2596,398,718,2604,974,589,2612,973,396,2620,716,2628,972,587,2636,971,394,2644,714,970,2652,585,2660,969,392,2668,712,968,2676,264,266,2684,268,270,2692,272,2700,274,276,2708,278,280,2716,282,284,2724,286,2732,288,290,2740,292,294,2748,296,298,2756,300,2764,302,304,2772,306,308,2780,310,312,2788,314,2796,316,318,2804,583,967,2812,262,390,2820,710,966,2828,198,2836,200,202,2844,204,206,2852,208,210,2860,212,2868,214,216,2876,218,220,2884,222,224,2892,226,2900,228,230,2908,232,234,2916,236,238,2924,240,2932,242,244,2940,246,248,2948,250,252,2956,254,581,2964,965,2972,196,260,2980,388,708,2988,964,579,2996,963,3004,68,70,3012,72,74,3020,76,78,3028,80,3036,82,84,3044,86,88,3052,90,92,3060,94,3068,96,98,3076,100,102,3084,104,106,3092,108,110,3100,112,3108,114,116,3116,118,120,3124,122,124,3132,126,3140,66,194,3148,258,386,3156,706,962,3164,577,3172,961,64,3180,192,256,3188,384,704,3196,960,3204,1791,830,2053,1790,1789,2061,828,1788,2069,1787,826,2077,1786,2085,1785,824,2093,1784,1783,2101,822,1782,2109,1781,2117,820,1780,2125,1779,818,2133,1778,1777,2141,816,2149,1776,1775,2157,814,1774,2165,1773,812,2173,1772,1771,2181,810,2189,1770,1769,2197,808,1641,2205,1643,1645,2213,1647,2221,1649,1651,2229,1653,1655,2237,1657,1659,2245,1661,2253,1663,1768,2261,1639,1767,2269,806,1766,2277,1637,2285,1765,804,2293,1764,1635,2301,1763,802,2309,1762,1633,2317,1761,2325,800,1760,2333,1631,1759,2341,798,1758,2349,1629,2357,1757,796,2365,1756,1627,2373,1755,794,2381,1754,2389,1625,1753,2397,792,1752,2405,1623,1751,2413,790,2421,1750,1621,2429,1749,788,2437,1748,1619,2445,1747,786,2453,1746,2461,1617,1745,2469,784,1744,2477,1615,1743,2485,1424,2493,1426,1428,2501,1430,1432,2509,1434,1436,2517,1438,2525,1440,1442,2533,1444,1446,2541,1448,1450,2549,1452,2557,1454,1456,2565,1458,1460,2573,1462,1464,2581,1466,1468,2589,1470,2597,782,1422,2605,1742,1613,2613,1741,780,2621,1420,2629,1740,1611,2637,1739,778,2645,1418,1738,2653,1609,2661,1737,776,2669,1416,1736,2677,1288,1290,2685,1292,1294,2693,1296,2701,1298,1300,2709,1302,1304,2717,1306,1308,2725,1310,2733,1312,1314,2741,1316,1318,2749,1320,1322,2757,1324,2765,1326,1328,2773,1330,1332,2781,1334,1336,2789,1338,2797,1340,1342,2805,1607,1735,2813,774,1286,2821,1414,1734,2829,1222,2837,1224,1226,2845,1228,1230,2853,1232,1234,2861,1236,2869,1238,1240,2877,1242,1244,2885,1246,1248,2893,1250,2901,1252,1254,2909,1256,1258,2917,1260,1262,2925,1264,2933,1266,1268,2941,1270,1272,2949,1274,1276,2957,1278,1605,2965,1733,2973,772,1220,2981,1284,1412,2989,1732,1603,2997,1731,3005,1092,1094,3013,1096,1098,3021,1100,1102,3029,1104,3037,1106,1108,3045,1110,1112,3053,1114,1116,3061,1118,3069,1120,1122,3077,1124,1126,3085,1128,1130,3093,1132,1134,3101,1136,3109,1138,1140,3117,1142,1144,3125,1146,1148,3133,1150,3141,770,1090,3149,1218,1282,3157,1410,1730,3165,1601,3173,1729,768,3181,1088,1216,3189,1280,1408,3197,1728,3205,1855,894,2054,1854,1853,2062,892,1852,2070,1851,890,2078,1850,2086,1849,888,2094,1848,1847,2102,886,1846,2110,1845,2118,884,1844,2126,1843,882,2134,1842,1841,2142,880,2150,1840,1839,2158,878,1838,2166,1837,876,2174,1836,1835,2182,874,2190,1834,1833,2198,616,618,2206,620,622,2214,624,2222,626,628,2230,630,632,2238,634,636,2246,638,2254,872,1832,2262,1831,614,2270,870,1830,2278,1829,2286,612,868,2294,1828,1827,2302,610,866,2310,1826,1825,2318,608,2326,864,1824,2334,1823,606,2342,862,1822,2350,1821,2358,604,860,2366,1820,1819,2374,602,858,2382,1818,2390,1817,600,2398,856,1816,2406,1815,598,2414,854,2422,1814,1813,2430,596,852,2438,1812,1811,2446,594,850,2454,1810,2462,1809,592,2470,848,1808,2478,1807,399,2486,401,2494,403,405,2502,407,409,2510,411,413,2518,415,2526,417,419,2534,421,423,2542,425,427,2550,429,2558,431,433,2566,435,437,2574,439,441,2582,443,445,2590,447,2598,590,846,2606,1806,397,2614,1805,588,2622,844,2630,1804,395,2638,1803,586,2646,842,1802,2654,393,2662,1801,584,2670,840,1800,2678,265,267,2686,269,271,2694,273,2702,275,277,2710,279,281,2718,283,285,2726,287,2734,289,291,2742,293,295,2750,297,299,2758,301,2766,303,305,2774,307,309,2782,311,313,2790,315,2798,317,319,2806,263,391,2814,1799,582,2822,838,1798,2830,197,2838,199,201,2846,203,205,2854,207,209,2862,211,2870,213,215,2878,217,219,2886,221,223,2894,225,2902,227,229,2910,231,233,2918,235,237,2926,239,2934,241,243,2942,245,247,2950,249,251,2958,253,255,2966,261,2974,389,1797,2982,580,836,2990,1796,195,2998,259,3006,387,1795,3014,67,69,3022,71,73,3030,75,3038,77,79,3046,81,83,3054,85,87,3062,89,3070,91,93,3078,95,97,3086,99,101,3094,103,105,3102,107,3110,109,111,3118,113,115,3126,117,119,3134,121,3142,123,125,3150,127,578,3158,834,1794,3166,65,3174,193,257,3182,385,1793,3190,576,832,3198,1792,3206,1919,958,2055,1918,1917,2063,956,1916,2071,1915,954,2079,1914,2087,1913,952,2095,1912,1911,2103,950,1910,2111,1909,2119,948,1908,2127,1907,946,2135,1906,1905,2143,944,2151,1904,1903,2159,942,1902,2167,1901,940,2175,1900,1899,2183,938,2191,1898,1897,2199,936,1640,2207,1642,1644,2215,1646,2223,1648,1650,2231,1652,1654,2239,1656,1658,2247,1660,2255,1662,1896,2263,1895,934,2271,1638,1894,2279,1893,2287,932,1636,2295,1892,1891,2303,930,1634,2311,1890,1889,2319,928,2327,1632,1888,2335,1887,926,2343,1630,1886,2351,1885,2359,924,1628,2367,1884,1883,2375,922,1626,2383,1882,2391,1881,920,2399,1624,1880,2407,1879,918,2415,1622,2423,1878,1877,2431,916,1620,2439,1876,1875,2447,914,1618,2455,1874,2463,1873,912,2471,1616,1872,2479,1871,1423,2487,1425,2495,1427,1429,2503,1431,1433,2511,1435,1437,2519,1439,2527,1441,1443,2535,1445,1447,2543,1449,1451,2551,1453,2559,1455,1457,2567,1459,1461,2575,1463,1465,2583,1467,1469,2591,1471,2599,910,1614,2607,1870,1421,2615,1869,908,2623,1612,2631,1868,1419,2639,1867,906,2647,1610,1866,2655,1417,2663,1865,904,2671,1608,1864,2679,1289,1291,2687,1293,1295,2695,1297,2703,1299,1301,2711,1303,1305,2719,1307,1309,2727,1311,2735,1313,1315,2743,1317,1319,2751,1321,1323,2759,1325,2767,1327,1329,2775,1331,1333,2783,1335,1337,2791,1339,2799,1341,1343,2807,1287,1415,2815,1863,902,2823,1606,1862,2831,1221,2839,1223,1225,2847,1227,1229,2855,1231,1233,2863,1235,2871,1237,1239,2879,1241,1243,2887,1245,1247,2895,1249,2903,1251,1253,2911,1255,1257,2919,1259,1261,2927,1263,2935,1265,1267,2943,1269,1271,2951,1273,1275,2959,1277,1279,2967,1285,2975,1413,1861,2983,900,1604,2991,1860,1219,2999,1283,3007,1411,1859,3015,1091,1093,3023,1095,1097,3031,1099,3039,1101,1103,3047,1105,1107,3055,1109,1111,3063,1113,3071,1115,1117,3079,1119,1121,3087,1123,1125,3095,1127,1129,3103,1131,3111,1133,1135,3119,1137,1139,3127,1141,1143,3135,1145,3143,1147,1149,3151,1151,898,3159,1602,1858,3167,1089,3175,1217,1281,3183,1409,1857,3191,896,1600,3199,1856,3207};
__device__ const unsigned short ATT_OFF[9] = {0,401,802,1203,1604,2005,2406,2807,3208};
namespace att {
constexpr int STG = 65536;
__device__ __forceinline__ void att_pop(LAS int* qs, unsigned* qheads) {
    const unsigned myx = (unsigned)__builtin_amdgcn_s_getreg((3 << 11) | 20) & 7u;
    int li = qs[2], item = -1;
    while (li < 8) { const unsigned x = (myx + (unsigned)li) & 7u; const unsigned idx = __hip_atomic_fetch_add(qheads + 64 * x, 1u, __ATOMIC_RELAXED, __HIP_MEMORY_SCOPE_AGENT);
        if (idx < (unsigned)(ATT_OFF[x + 1] - ATT_OFF[x])) { item = ATT_ITEMS[ATT_OFF[x] + idx]; break; } ++li; }
    qs[0] = item; qs[2] = li;
}
__device__ __forceinline__ const char* uni_ptr(const char* p) { const unsigned long long v = (unsigned long long)p; const unsigned lo = __builtin_amdgcn_readfirstlane((unsigned)v), hi = __builtin_amdgcn_readfirstlane((unsigned)(v >> 32)); return (const char*)(((unsigned long long)hi << 32) | lo); }
#define KSWZ(row, colB) ((row) * 256 + ((colB) ^ (((row) & 7) << 4)))
__device__ __forceinline__ int crow(int r, int hi) { return (r & 3) + 8 * (r >> 2) + 4 * hi; }
__device__ __forceinline__ int v_rd_base(int lane) { return ((lane & 3) << 3) | (((lane >> 2) & 3) << 6) | (((lane >> 4) & 1) << 5) | (((lane >> 5) & 1) << 8); }
constexpr int v_rd_off(int d0, int ks, int half) { return d0 * 512 + ks * 4096 + half * 2048; }
template <int OFF> __device__ __forceinline__ s16x4 tr_read(int vb) { s16x4 r; asm volatile("ds_read_b64_tr_b16 %0, %1 offset:%2" : "=&v"(r) : "v"(vb), "i"(OFF) : "memory"); return r; }
template <int D0> __device__ __forceinline__ void pv_one(f32x16& od, int vb, bf16x8 pa0, bf16x8 pa1, bf16x8 pa2, bf16x8 pa3) {
    const s16x4 l0 = tr_read<v_rd_off(D0, 0, 0)>(vb), h0 = tr_read<v_rd_off(D0, 0, 1)>(vb), l1 = tr_read<v_rd_off(D0, 1, 0)>(vb), h1 = tr_read<v_rd_off(D0, 1, 1)>(vb);
    const s16x4 l2 = tr_read<v_rd_off(D0, 2, 0)>(vb), h2 = tr_read<v_rd_off(D0, 2, 1)>(vb), l3 = tr_read<v_rd_off(D0, 3, 0)>(vb), h3 = tr_read<v_rd_off(D0, 3, 1)>(vb);
    asm volatile("s_waitcnt lgkmcnt(0)" ::: "memory"); __builtin_amdgcn_sched_barrier(0);
#define PK(L, H) (bf16x8){L[0], L[1], L[2], L[3], H[0], H[1], H[2], H[3]}
    od = __builtin_amdgcn_mfma_f32_32x32x16_bf16(pa0, PK(l0, h0), od, 0, 0, 0);
    od = __builtin_amdgcn_mfma_f32_32x32x16_bf16(pa1, PK(l1, h1), od, 0, 0, 0);
    od = __builtin_amdgcn_mfma_f32_32x32x16_bf16(pa2, PK(l2, h2), od, 0, 0, 0);
    od = __builtin_amdgcn_mfma_f32_32x32x16_bf16(pa3, PK(l3, h3), od, 0, 0, 0);
#undef PK
}
template <int D0> __device__ __forceinline__ void pv_ld(s16x4 (&t)[8], int vb) {
    constexpr int B = (D0 >> 2) * 16384, D = D0 & 3;
    t[0] = tr_read<B + v_rd_off(D, 0, 0)>(vb); t[1] = tr_read<B + v_rd_off(D, 0, 1)>(vb); t[2] = tr_read<B + v_rd_off(D, 1, 0)>(vb); t[3] = tr_read<B + v_rd_off(D, 1, 1)>(vb);
    t[4] = tr_read<B + v_rd_off(D, 2, 0)>(vb); t[5] = tr_read<B + v_rd_off(D, 2, 1)>(vb); t[6] = tr_read<B + v_rd_off(D, 3, 0)>(vb); t[7] = tr_read<B + v_rd_off(D, 3, 1)>(vb);
}
__device__ __forceinline__ void pv_mm(f32x16& od, const s16x4 (&t)[8], bf16x8 pa0, bf16x8 pa1, bf16x8 pa2, bf16x8 pa3) {
#define PK(L, H) (bf16x8){L[0], L[1], L[2], L[3], H[0], H[1], H[2], H[3]}
    od = __builtin_amdgcn_mfma_f32_32x32x16_bf16(pa0, PK(t[0], t[1]), od, 0, 0, 0);
    od = __builtin_amdgcn_mfma_f32_32x32x16_bf16(pa1, PK(t[2], t[3]), od, 0, 0, 0);
    od = __builtin_amdgcn_mfma_f32_32x32x16_bf16(pa2, PK(t[4], t[5]), od, 0, 0, 0);
    od = __builtin_amdgcn_mfma_f32_32x32x16_bf16(pa3, PK(t[6], t[7]), od, 0, 0, 0);
#undef PK
}
#define PV_WAIT(n) do { asm volatile("s_waitcnt lgkmcnt(" #n ")" ::: "memory"); __builtin_amdgcn_sched_barrier(0); } while (0)
__device__ __forceinline__ void pv_all(f32x16 (&o)[8], int vb, bf16x8 pa0, bf16x8 pa1, bf16x8 pa2, bf16x8 pa3) {
    s16x4 ta[8], tb[8];
    pv_ld<0>(ta, vb);
    pv_ld<1>(tb, vb); PV_WAIT(8); pv_mm(o[0], ta, pa0, pa1, pa2, pa3);
    pv_ld<2>(ta, vb); PV_WAIT(8); pv_mm(o[1], tb, pa0, pa1, pa2, pa3);
    pv_ld<3>(tb, vb); PV_WAIT(8); pv_mm(o[2], ta, pa0, pa1, pa2, pa3);
    pv_ld<4>(ta, vb); PV_WAIT(8); pv_mm(o[3], tb, pa0, pa1, pa2, pa3);
    pv_ld<5>(tb, vb); PV_WAIT(8); pv_mm(o[4], ta, pa0, pa1, pa2, pa3);
    pv_ld<6>(ta, vb); PV_WAIT(8); pv_mm(o[5], tb, pa0, pa1, pa2, pa3);
    pv_ld<7>(tb, vb); PV_WAIT(8); pv_mm(o[6], ta, pa0, pa1, pa2, pa3);
    PV_WAIT(0); pv_mm(o[7], tb, pa0, pa1, pa2, pa3);
}
#define ATT_BAR() do { asm volatile("s_waitcnt vmcnt(0) lgkmcnt(0)" ::: "memory"); __builtin_amdgcn_s_barrier(); asm volatile("" ::: "memory"); } while (0)

template <int VAR  >
__device__ __forceinline__ void attn_unit(LAS unsigned char* lds, LAS float* scr, const bf16_t* Qg, const bf16_t* Kg, const bf16_t* Vg, bf16_t* Og,
                                          int b, int h, int qb, float lam, float slope2, const float* subln_g, const unsigned* kn, int wid, int lane, LAS int* qs, unsigned* qheads) {
    asm volatile("" : "+v"(lane));
    const int mp = wid >> 2, rq = wid & 3, r32 = lane & 31, hi = lane >> 5;
    const int q0 = qb * 128, NT = 2 * qb + 2;
    const size_t rowbase = (size_t)b * SEQ;
    unsigned koff[2], voff[2];
#pragma unroll
    for (int j = 0; j < 2; ++j) {
        const int blk = j * 8 + wid;
        { const int row = blk * 4 + (lane >> 4), chunk = (lane & 15) ^ (row & 7); koff[j] = (unsigned)(row * D_MODEL + chunk * 8) * 2u; }
        { const int sub = blk * 2 + (lane >> 5), kk = (sub >> 2) * 8 + ((lane & 31) >> 2), k = (kk & ~0xC) | ((kk & 4) << 1) | ((kk & 8) >> 1);
          voff[j] = (unsigned)(k * D_MODEL + (sub & 3) * 32 + (lane & 3) * 8) * 2u; }
    }
    const char* Kh = uni_ptr((const char*)(Kg + rowbase * D_MODEL + h * 256));
    const char* Vh = uni_ptr((const char*)(Vg + rowbase * D_MODEL + h * 256));
#define ATT_ISSUE(t, stg) do { const char* kt_ = Kh + (size_t)(t) * (64 * D_MODEL * 2); const char* vt_ = Vh + (size_t)(t) * (64 * D_MODEL * 2); LAS unsigned char* sb_ = lds + (stg) * STG + wid * 1024; \
        _Pragma("unroll") for (int i_ = 0; i_ < 8; ++i_) { const char* ub_ = (i_ < 4) ? kt_ + (i_ >> 1) * 256 : vt_ + ((i_ >> 1) & 1) * 256; const unsigned vo_ = (i_ < 4) ? koff[i_ & 1] : voff[i_ & 1]; \
            __builtin_amdgcn_global_load_lds((const unsigned*)(ub_ + vo_), (LAS unsigned*)(sb_ + i_ * 8192), 16, 0, 0); } } while (0)
    ATT_ISSUE(NT - 1, 0);
    bf16x8 qr[8];
    { const bf16_t* Qw = Qg + (rowbase + q0 + 32 * rq + r32) * D_MODEL + h * 256 + mp * 128 + hi * 8;
#pragma unroll
      for (int d0 = 0; d0 < 8; ++d0) qr[d0] = *(const bf16x8*)(Qw + d0 * 16); }
    int kb[16];
#pragma unroll
    for (int r = 0; r < 16; ++r) { const float kv = slope2 * (float)((r & 3) + 8 * (r >> 2)); asm volatile("s_nop 0\n\tv_readfirstlane_b32 %0, %1" : "=s"(kb[r]) : "v"(kv)); }
    const float off32 = 32.f * slope2;
    f32x16 o[8];
#pragma unroll
    for (int d = 0; d < 8; ++d) o[d] = (f32x16){0.f, 0.f, 0.f, 0.f, 0.f, 0.f, 0.f, 0.f, 0.f, 0.f, 0.f, 0.f, 0.f, 0.f, 0.f, 0.f};
    float m_run = -1e30f, l_run = 0.f;
    const int vb0 = (int)(uintptr_t)(lds) + 32768 + v_rd_base(lane);
    LAS float* al_l = scr + wid * 64;
    { float q2 = 0.f;
#pragma unroll
      for (int d0 = 0; d0 < 8; ++d0) { const u32x4 w = __builtin_bit_cast(u32x4, qr[d0]);
          q2 += bflo(w.x) * bflo(w.x) + bfhi(w.x) * bfhi(w.x) + bflo(w.y) * bflo(w.y) + bfhi(w.y) * bfhi(w.y) + bflo(w.z) * bflo(w.z) + bfhi(w.z) * bfhi(w.z) + bflo(w.w) * bflo(w.w) + bfhi(w.w) * bfhi(w.w); }
      { auto rr = __builtin_amdgcn_permlane32_swap(__float_as_uint(q2), __float_as_uint(q2), false, false); q2 = __uint_as_float(rr[0]) + __uint_as_float(rr[1]); }
      q2 = fmaxf(q2, swz_xor<1>(q2)); q2 = fmaxf(q2, swz_xor<2>(q2)); q2 = fmaxf(q2, swz_xor<4>(q2)); q2 = fmaxf(q2, swz_xor<8>(q2)); q2 = fmaxf(q2, swz_xor<16>(q2));
      if (lane == 0) al_l[40] = q2; }
    int jmax = NT;
    if (wid >= 4) __builtin_amdgcn_s_setprio(1);
    for (int j = 0; j < jmax; ++j) {
        const int t = NT - 1 - j, stg = j & 1;
        ATT_BAR();
        if (j == 0) {
            float q2m = 0.f;
#pragma unroll
            for (int w8 = 0; w8 < 8; ++w8) q2m = fmaxf(q2m, scr[w8 * 64 + 40]);
            const unsigned* kp = kn + ((b * 16 + h) * 2) * 4;
            const float k2 = 1.02f * fmaxf((__uint_as_float(kp[0]) + __uint_as_float(kp[1])) + (__uint_as_float(kp[2]) + __uint_as_float(kp[3])), (__uint_as_float(kp[4]) + __uint_as_float(kp[5])) + (__uint_as_float(kp[6]) + __uint_as_float(kp[7])));
            const float W = (158.f + 2.f * sqrtf(q2m * k2)) / slope2;
            const float xs = ((float)(q0 - 63) - W) * (1.f / 64.f);
            int ts = xs > 0.f ? (int)ceilf(xs) : 0; ts = ts < NT - 2 ? ts : NT - 2;
            jmax = NT - __builtin_amdgcn_readfirstlane(ts);
        }
        if (j + 1 < jmax) ATT_ISSUE(t - 1, stg ^ 1);
        const LAS unsigned char* Ks = lds + stg * STG + mp * 16384;
        f32x16 p0, p1;
#pragma unroll
        for (int r = 0; r < 16; ++r) { int sb = kb[r]; asm volatile("" : "+s"(sb)); p0[r] = __int_as_float(sb); p1[r] = __int_as_float(sb); }
#pragma unroll
        for (int d0 = 0; d0 < 8; ++d0) { const int cb = (d0 * 16 + hi * 8) * 2;
            const bf16x8 b0 = *(const LAS bf16x8*)(Ks + KSWZ(r32, cb)), b1 = *(const LAS bf16x8*)(Ks + KSWZ(32 + r32, cb));
            p0 = __builtin_amdgcn_mfma_f32_32x32x16_bf16(b0, qr[d0], p0, 0, 0, 0);
            p1 = __builtin_amdgcn_mfma_f32_32x32x16_bf16(b1, qr[d0], p1, 0, 0, 0);
            if ((d0 & 3) == 3) asm volatile("" ::: "memory"); }
        if (t >= NT - 2) {
            const int lim = q0 + 32 * rq + r32 - 64 * t - 4 * hi;
#pragma unroll
            for (int r = 0; r < 16; ++r) { const int cr = (r & 3) + 8 * (r >> 2); p0[r] = (cr > lim) ? -__builtin_inff() : p0[r]; p1[r] = (cr + 32 > lim) ? -__builtin_inff() : p1[r]; }
        }
        const float gt = slope2 * (float)(64 * (t - NT) + 4 * hi);
        float pmax = p0[0], pmax1 = p1[0];
#pragma unroll
        for (int r = 1; r < 16; ++r) { if (VAR < 2) { pmax = fmaxf(pmax, p0[r]); pmax1 = fmaxf(pmax1, p1[r]); } }
        pmax = fmaxf(pmax, pmax1 + off32) + gt;
        { auto rr = __builtin_amdgcn_permlane32_swap(__float_as_uint(pmax), __float_as_uint(pmax), false, false); pmax = fmaxf(__uint_as_float(rr[0]), __uint_as_float(rr[1])); }
        float alpha = 1.f;
        if (!__all(pmax - m_run <= 8.f)) { const float mn = fmaxf(m_run, pmax); alpha = __builtin_amdgcn_exp2f(m_run - mn); m_run = mn; }
        const float mm = m_run - gt, mm1 = mm - off32;
        float ps = 0.f;
#pragma unroll
        for (int r = 0; r < 16; ++r) { if (VAR == 0) { p0[r] = __builtin_amdgcn_exp2f(p0[r] - mm); p1[r] = __builtin_amdgcn_exp2f(p1[r] - mm1); ps += p0[r] + p1[r]; }
            else if (VAR == 1) { p0[r] = (p0[r] - mm) * 1e-3f; p1[r] = (p1[r] - mm1) * 1e-3f; ps += p0[r] + p1[r]; } }
        { auto rr = __builtin_amdgcn_permlane32_swap(__float_as_uint(ps), __float_as_uint(ps), false, false); ps = __uint_as_float(rr[0]) + __uint_as_float(rr[1]); }
        l_run = l_run * alpha + ps;
        bf16x8 pa0, pa1, pa2, pa3;
#define PK4(P, BASE, OUT) do { const unsigned a0 = cvt_pk_bf16(P[BASE + 0], P[BASE + 1]), a1 = cvt_pk_bf16(P[BASE + 2], P[BASE + 3]);   \
    const unsigned b0 = cvt_pk_bf16(P[BASE + 4], P[BASE + 5]), b1 = cvt_pk_bf16(P[BASE + 6], P[BASE + 7]);                              \
    auto r0 = __builtin_amdgcn_permlane32_swap(a0, b0, false, false); auto r1 = __builtin_amdgcn_permlane32_swap(a1, b1, false, false); \
    u32x4 w = {r0[0], r1[0], r0[1], r1[1]}; OUT = *reinterpret_cast<bf16x8*>(&w); } while (0)
        PK4(p0, 0, pa0); PK4(p0, 8, pa1); PK4(p1, 0, pa2); PK4(p1, 8, pa3);
#undef PK4
        if (__any(alpha < 1.f)) {
            if (hi == 0) al_l[r32] = alpha;
            asm volatile("s_waitcnt lgkmcnt(0)" ::: "memory");
#pragma unroll
            for (int r = 0; r < 16; ++r) { const float a = al_l[crow(r, hi)];
#pragma unroll
                for (int d = 0; d < 8; ++d) o[d][r] *= a; }
        }
        const int vb = vb0 + stg * STG;
        pv_all(o, vb, pa0, pa1, pa2, pa3);
    }
    __builtin_amdgcn_s_setprio(0);
    ATT_BAR();
    { int l2 = lane; asm volatile("" : "+v"(l2)); lane = l2; }
    const int r32e = lane & 31, hie = lane >> 5;
    if (hie == 0) al_l[r32e] = l_run;
    asm volatile("s_waitcnt lgkmcnt(0)" ::: "memory");
#pragma unroll
    for (int r = 0; r < 16; ++r) { float a = __builtin_amdgcn_rcpf(al_l[(r & 3) + 8 * (r >> 2) + 4 * hie]); if (mp == 1) a *= lam;
#pragma unroll
        for (int d = 0; d < 8; ++d) o[d][r] *= a; }
    LAS float* X = (LAS float*)(lds + rq * 32768) + lane;
    if (mp == 1) {
#pragma unroll
        for (int d = 0; d < 8; ++d) {
#pragma unroll
            for (int r = 0; r < 16; ++r) X[(d * 16 + r) * 64] = o[d][r];
            asm volatile("" ::: "memory"); }
    }
    ATT_BAR();
    if (mp == 0) {
        float ss[16];
#pragma unroll
        for (int r = 0; r < 16; ++r) ss[r] = 0.f;
#pragma unroll
        for (int d = 0; d < 8; ++d) {
#pragma unroll
            for (int r = 0; r < 16; ++r) { const float v = o[d][r] - X[(d * 16 + r) * 64]; X[(d * 16 + r) * 64] = v; ss[r] += v * v; if (r == 7) asm volatile("" ::: "memory"); }
            asm volatile("" ::: "memory"); }
#pragma unroll
        for (int r = 0; r < 16; ++r) { const float f = rsqrtf(half_sum(ss[r]) * (1.0f / V_HEAD_DIM) + LN_EPS) * (1.0f - LAM_INIT); if (r32e == 0) al_l[(r & 3) + 8 * (r >> 2) + 4 * hie] = f; }
        asm volatile("s_waitcnt lgkmcnt(0)" ::: "memory");
        const f32x4 g0 = *(const f32x4*)(subln_g + 8 * r32e), g1 = *(const f32x4*)(subln_g + 8 * r32e + 4);
        const LAS float* Xr = (const LAS float*)(lds + rq * 32768) + (r32e >> 2) * 1024 + (r32e & 3) * 8;
        bf16_t* Ow = Og + (rowbase + q0 + 32 * rq + hie) * D_MODEL + h * 256 + 8 * r32e;
#pragma unroll
        for (int j = 0; j < 16; ++j) { int q = 2 * j; asm volatile("" : "+v"(q)); q += hie;
            const int rr = (q & 3) + 4 * (q >> 3), hh = (q >> 2) & 1;
            const LAS float* xp = Xr + rr * 64 + hh * 32; const f32x4 v0 = *(const LAS f32x4*)xp, v1 = *(const LAS f32x4*)(xp + 4); const float f = al_l[q];
            *(u32x4*)(Ow + (size_t)(2 * j) * D_MODEL) = pg8::pack8(v0 * f * g0, v1 * f * g1); }
    }
    else if (wid == 4 && r32e == 0 && hie == 0) att_pop(qs, qheads);
    ATT_BAR();
#undef ATT_ISSUE
}
}

constexpr size_t MiB = 1u << 20;
constexpr size_t WS_CTL = 0, CTL_ZERO_BYTES = 65536;
constexpr size_t WS_STATV = 2 * MiB, WS_STAT1 = 10 * MiB, WS_STAT2 = 14 * MiB, WS_STAT3 = 18 * MiB, WS_DIAG = 22 * MiB, WS_PB = 24 * MiB;
constexpr size_t WS_WIN = 32 * MiB, WS_WGU = 256 * MiB, WS_WDOWN = 428 * MiB, WS_WA = 514 * MiB, WS_WB = 546 * MiB, WS_WO = 578 * MiB, WS_WPG = 610 * MiB, WS_WPP = 642 * MiB;
constexpr size_t WS_H = 648 * MiB;
constexpr size_t WS_ACT = 776 * MiB, ACT_STRIDE = 128 * MiB;
constexpr size_t WS_GU = WS_ACT, WS_GV = WS_ACT + ACT_STRIDE, WS_Q = WS_ACT + 2 * ACT_STRIDE, WS_K = WS_ACT + 3 * ACT_STRIDE, WS_V = WS_ACT + 4 * ACT_STRIDE, WS_SA = WS_ACT + 5 * ACT_STRIDE, WS_SB = WS_ACT + 6 * ACT_STRIDE;
constexpr size_t WS_X3 = WS_SA;
constexpr size_t WS_WIN8 = WS_WIN + (size_t)5 * D_MODEL * D_MODEL * 2;
constexpr size_t WS_H8 = WS_ACT + 7 * ACT_STRIDE;
constexpr size_t WS_X8 = WS_SB;
constexpr size_t WS_MERGED = WS_GV, WS_PP = WS_K, WS_HID = WS_ACT;
constexpr size_t WS_END = WS_H8 + 64 * MiB;
static_assert(WS_WPP + 2 * MiB <= WS_H && WS_H + 128 * MiB <= WS_ACT && (size_t)M_TOK * D_FF * 2 <= 3 * ACT_STRIDE, "d_ws map");
constexpr int CW_BAR = 4096;
constexpr int CW_ATTQ = 8192;
constexpr int CW_KN = 12288;
static_assert((CW_KN + 2 * 16 * 2 * 4) * 4 <= (int)CTL_ZERO_BYTES && (CW_ATTQ + 1024) <= CW_KN && (CW_BAR + 3456) <= CW_ATTQ, "control words inside the per-call memset");


constexpr int RING_OFF = 0, RING_BYTES = 131072, ATT_SCR_OFF = RING_BYTES, LDSCTL_OFF = RING_BYTES + 2048, MISC_OFF = LDSCTL_OFF + 320, ATT_Q_OFF = MISC_OFF + 256, RS_OFF = MISC_OFF + 512, LDS_BYTES = 147456;
constexpr int NWAVES = 8;

#define XB_TMO      128
#define XB_XCNT(j)  (256  + 64 * (j))
#define XB_XSUB(j)  (1280 + 64 * (j))
#define XB_XGEN(j)  (2304 + 64 * (j))
#define XB_TOP      3328
#define XB_TOPGEN   3392
#define XCD_BAR_WORDS 3456
#define XB_SPIN_CAP (1u << 22)
__device__ __forceinline__ unsigned xb_ld(unsigned* p)              { return __hip_atomic_load(p, __ATOMIC_RELAXED, __HIP_MEMORY_SCOPE_AGENT); }
__device__ __forceinline__ unsigned xb_add(unsigned* p, unsigned v) { return __hip_atomic_fetch_add(p, v, __ATOMIC_RELAXED, __HIP_MEMORY_SCOPE_AGENT); }
__device__ __forceinline__ unsigned xb_xcc_id() { return (unsigned)__builtin_amdgcn_s_getreg((3 << 11) | 20) & 0xFu; }
#define XB_SPIN(cond, bar) do { unsigned _sp = 0; while (cond) { __builtin_amdgcn_s_sleep(1); \
    if ((++_sp & 255u) == 0u) { if (xb_ld(&(bar)[XB_TMO])) break; if (_sp > XB_SPIN_CAP) { atomicAdd(&(bar)[XB_TMO], 1u); break; } } } } while (0)
struct XcdBarrier { unsigned* bar; unsigned x; volatile LAS unsigned* st; };
__device__ __forceinline__ XcdBarrier xcd_barrier_post(unsigned* bar, volatile LAS unsigned* st) {
    XcdBarrier b; b.bar = bar; b.x = xb_xcc_id(); b.st = st;
    if (threadIdx.x == 0) (void)xb_add(&bar[XB_XCNT(b.x)], 1u);
    return b;
}
__device__ __forceinline__ void xcd_barrier_complete(unsigned* bar, unsigned x, unsigned& nloc, unsigned& nx) {
    const unsigned G = gridDim.x * gridDim.y * gridDim.z;
    unsigned sum, cnt, mine, sp = 0u;
    for (;;) {
        sum = 0u; cnt = 0u; mine = 0u;
#pragma unroll
        for (unsigned j = 0; j < 16; ++j) { const unsigned c = xb_ld(&bar[XB_XCNT(j)]); sum += c; cnt += (c > 0u) ? 1u : 0u; mine = (j == x) ? c : mine; }
        if (sum == G) break;
        __builtin_amdgcn_s_sleep(1);
        if ((++sp & 255u) == 0u) { if (xb_ld(&bar[XB_TMO])) break; if (sp > XB_SPIN_CAP) { atomicAdd(&bar[XB_TMO], 1u); break; } }
    }
    nloc = mine > 0u ? mine : 1u; nx = cnt > 0u ? cnt : 1u;
}
__device__ __forceinline__ void xcd_barrier(const XcdBarrier& b, const int wave) {
    asm volatile("s_waitcnt vmcnt(0)" ::: "memory");
    __syncthreads();
    if (wave == 0 && lane_id() == 0) {
        unsigned* bar = b.bar;
        __builtin_amdgcn_s_waitcnt(0);
        unsigned nloc = b.st[0], nx = b.st[1];
        if (nloc == 0u) { xcd_barrier_complete(bar, b.x, nloc, nx); b.st[0] = nloc; b.st[1] = nx; }
        const unsigned old = xb_add(&bar[XB_XSUB(b.x)], 1u);
        const unsigned gen = old / nloc;
        if (old + 1u == (gen + 1u) * nloc) {
            __builtin_amdgcn_fence(__ATOMIC_RELEASE, "agent");
            asm volatile("s_waitcnt vmcnt(0)" ::: "memory");
            const unsigned og = xb_add(&bar[XB_TOP], 1u);
            const unsigned tg = og / nx;
            if (og + 1u == (tg + 1u) * nx) xb_add(&bar[XB_TOPGEN], 1u);
            else XB_SPIN(xb_ld(&bar[XB_TOPGEN]) == tg, bar);
            __builtin_amdgcn_fence(__ATOMIC_ACQUIRE, "agent");
            xb_add(&bar[XB_XGEN(b.x)], 1u);
            asm volatile("s_waitcnt vmcnt(0)" ::: "memory");
        } else {
            XB_SPIN(xb_ld(&bar[XB_XGEN(b.x)]) == gen, bar);
            __builtin_amdgcn_fence(__ATOMIC_ACQUIRE, "agent");
            asm volatile("s_waitcnt vmcnt(0)" ::: "memory");
        }
    }
    __syncthreads();
}

template <bool NT> __device__ __forceinline__ void p0_load(f32x4 (&v)[8], const float* W, int N, int k0, int src0, int lane) {
    const int kr = lane >> 3, nc = (lane & 7) * 4;
#pragma unroll
    for (int i = 0; i < 8; ++i) { const GAS f32x4* p = (const GAS f32x4*)(W + (size_t)(k0 + 8 * i + kr) * N + src0 + nc); v[i] = NT ? __builtin_nontemporal_load(p) : *p; }
}
template <bool NTS, bool F8 = false> __device__ __forceinline__ void p0_store(const f32x4 (&v)[8], int K, bf16_t* WT, const float* ksc, LAS float* scr, int k0, int n0, int lane) {
    const int kr = lane >> 3, nc = (lane & 7) * 4;
#pragma unroll
    for (int i = 0; i < 8; ++i) { const int kk = 8 * i + kr; const float sc = (ksc ? ksc[k0 + kk] : 1.f) * (F8 ? F8_SW : 1.f); LAS float* s = scr + kk * 33 + nc;
        s[0] = v[i][0] * sc; s[1] = v[i][1] * sc; s[2] = v[i][2] * sc; s[3] = v[i][3] * sc; }
    asm volatile("s_waitcnt lgkmcnt(0)" ::: "memory");
    const int c = lane & 7;
#pragma unroll
    for (int j = 0; j < 4; ++j) { const int n = (lane >> 3) + 8 * j; const LAS float* s = scr + (8 * c) * 33 + n;
        if constexpr (F8) { u32x2 o; o.x = pk_fp8x4(s[0 * 33], s[1 * 33], s[2 * 33], s[3 * 33]); o.y = pk_fp8x4(s[4 * 33], s[5 * 33], s[6 * 33], s[7 * 33]);
            *(GAS u32x2*)((unsigned char*)WT + (size_t)(n0 + n) * K + k0 + 8 * c) = o; }
        else {
        u32x4 o; o.x = cvt_pk_bf16(s[0 * 33], s[1 * 33]); o.y = cvt_pk_bf16(s[2 * 33], s[3 * 33]); o.z = cvt_pk_bf16(s[4 * 33], s[5 * 33]); o.w = cvt_pk_bf16(s[6 * 33], s[7 * 33]);
        if (NTS) __builtin_nontemporal_store(o, (GAS u32x4*)(WT + (size_t)(n0 + n) * K + k0 + 8 * c)); else *(GAS u32x4*)(WT + (size_t)(n0 + n) * K + k0 + 8 * c) = o; } }
    asm volatile("s_waitcnt lgkmcnt(0)" ::: "memory");
}
template <bool NTS, bool F8 = false> __device__ __forceinline__ void p0_item(const float* W, int N, int K, bf16_t* WT, const float* ksc, LAS float* scr, int k0, int n0, int src0, int lane) {
    f32x4 v[8]; p0_load<true>(v, W, N, k0, src0, lane); p0_store<NTS, F8>(v, K, WT, ksc, scr, k0, n0, lane);
}
template <int GU  > __device__ __forceinline__ void p0_matrix(const float* W, int K, int N, bf16_t* WT, const float* ksc, LAS float* scr, int gw, int NGW, int& base, int lane, bf16_t* WT8 = nullptr) {
    const int nblk = (WT8 ? 5 * D_MODEL : N) / 32, items = (K / 64) * nblk;
    int first = (gw - (base % NGW) + NGW) % NGW;
    for (int it = first; it < items; it += NGW) { const int kb = it / nblk, nb = it % nblk, n0 = nb * 32;
        int src0 = n0; if (GU == 1) { const int pn = n0 >> 8, bj = (n0 >> 7) & 1, ii = n0 & 127; src0 = bj * D_FF + pn * 128 + ii; }
        if (GU == 2 && n0 >= 5 * D_MODEL) { const int r = n0 - 5 * D_MODEL, jt = r >> 8, bj = (r >> 7) & 1, ii = r & 127; src0 = 5 * D_MODEL + bj * D_MODEL + jt * 128 + ii;
            p0_item<false, true>(W, N, K, WT8, ksc, scr, kb * 64, r, src0, lane); continue; }
        p0_item<(GU != 2)>(W, N, K, WT, ksc, scr, kb * 64, n0, src0, lane); }
    base += items;
}

__device__ __forceinline__ void fill_row_scale(LAS float* rs, const float* stat, int pm, int wave, int lane) {
#pragma unroll 8
    for (int i = 0; i < 32; ++i) { const int r = wave * 32 + i; const float s = wave_sum(stat[((size_t)pm * 256 + r) * 64 + lane]); if (lane == 0) rs[r] = rsqrtf(s * (1.f / D_MODEL) + RMS_EPS); }
    asm volatile("s_waitcnt lgkmcnt(0)" ::: "memory"); __syncthreads();
}
struct Args { const float* in[24]; float* out; unsigned char* ws; int ph_lo, ph_hi; };
enum { I_X = 0, I_P, I_GMIX, I_WIN, I_BGATE, I_LNVG, I_LNVB, I_WS, I_BS, I_LQ1, I_LK1, I_LQ2, I_LK2, I_SUBLN, I_WA, I_WB, I_WO, I_GFFN, I_WGU, I_WDOWN, I_GPLE, I_WPG, I_WPP, I_GFINAL };
constexpr int N_PHASES = 10;

typedef __attribute__((address_space(4))) const unsigned char* kptr_t;
__device__ __forceinline__ const float* karg_in(int i) { kptr_t ka = (kptr_t)__builtin_amdgcn_kernarg_segment_ptr(); asm volatile("" : "+s"(ka)); return *(const float* const __attribute__((address_space(4)))*)(ka + 8 * i); }
#define AIN(i) karg_in(i)
constexpr int CV_GU = (D_MODEL / 64) * (2 * D_FF / 32) / 128, CV_DOWN = (D_FF / 64) * (D_MODEL / 32) / 128, CV_SQ = (D_MODEL / 64) * (D_MODEL / 32) / 128, CV_PP = (PLE_DIM / 64) * (D_MODEL / 32) / 128;
constexpr int CV_CHUNKS = CV_GU + CV_DOWN + 4 * CV_SQ + CV_PP;
static_assert((D_MODEL / 64) * (2 * D_FF / 32) % 128 == 0 && (D_FF / 64) * (D_MODEL / 32) % 128 == 0 && (PLE_DIM / 64) * (D_MODEL / 32) % 128 == 0 && CV_CHUNKS == 776, "conversion chunks");
__device__ __forceinline__ void cv_load(f32x4 (&v)[8], float& kv, const float* W, int N, int k0, int src0, const float* kp, int lane) {
    const int kr = lane >> 3, nc = (lane & 7) * 4;
    const float* p = W + (size_t)(k0 + kr) * N + src0 + nc;
#pragma unroll
    for (int i = 0; i < 8; ++i) { v[i] = __builtin_nontemporal_load((const GAS f32x4*)p); p += (size_t)8 * N; }
    kv = *(const GAS float*)kp;
}
template <bool F8> __device__ __forceinline__ void cv_store(const f32x4 (&v)[8], float kv, int K, bf16_t* WT, LAS float* scr, int k0, int n0, int lane) {
    const int kr = lane >> 3, nc = (lane & 7) * 4;
#pragma unroll
    for (int i = 0; i < 8; ++i) { const int kk = 8 * i + kr; const float sc = __builtin_bit_cast(float, __builtin_amdgcn_ds_bpermute(kk * 4, __builtin_bit_cast(int, kv))); LAS float* s = scr + kk * 33 + nc;
        s[0] = v[i][0] * sc; s[1] = v[i][1] * sc; s[2] = v[i][2] * sc; s[3] = v[i][3] * sc; }
    asm volatile("s_waitcnt lgkmcnt(0)" ::: "memory");
    const int c = lane & 7;
#pragma unroll
    for (int j = 0; j < 4; ++j) { const int n = (lane >> 3) + 8 * j; const LAS float* s = scr + (8 * c) * 33 + n;
        if constexpr (F8) {
            u32x2 o; o.x = pk_fp8x4(s[0 * 33], s[1 * 33], s[2 * 33], s[3 * 33]); o.y = pk_fp8x4(s[4 * 33], s[5 * 33], s[6 * 33], s[7 * 33]);
            unsigned char* dst = (unsigned char*)WT + (size_t)(n0 + n) * K + k0 + 8 * c;
            asm volatile("global_store_dwordx2 %0, %1, off" :: "v"(dst), "v"(o) : "memory");
        } else {
        u32x4 o; o.x = cvt_pk_bf16(s[0 * 33], s[1 * 33]); o.y = cvt_pk_bf16(s[2 * 33], s[3 * 33]); o.z = cvt_pk_bf16(s[4 * 33], s[5 * 33]); o.w = cvt_pk_bf16(s[6 * 33], s[7 * 33]);
        bf16_t* dst = WT + (size_t)(n0 + n) * K + k0 + 8 * c;
        asm volatile("global_store_dwordx4 %0, %1, off" :: "v"(dst), "v"(o) : "memory"); } }
    asm volatile("s_waitcnt lgkmcnt(0)" ::: "memory");
}
template <bool F8> __device__ __forceinline__ void conv_body(int c, const float* W, const float* ksc, bf16_t* WT, int K, int N, int gu, LAS float* scr, int wave, int lane, int ndst = 0) {
    const bool has = ksc != nullptr;
    const int nblk = (ndst ? ndst : N) / 32; int it = c * 128 + wave;
#define CV_DECODE(it_, k0_, n0_, s0_) const int k0_ = ((it_) / nblk) * 64, n0_ = ((it_) % nblk) * 32; int s0_ = n0_; { const int pn = n0_ >> 8, bj = (n0_ >> 7) & 1, ii = n0_ & 127; \
        if (gu == 1) s0_ = bj * D_FF + pn * 128 + ii; else if (gu == 2) s0_ = 5 * D_MODEL + bj * D_MODEL + pn * 128 + ii; }
#define CV_LD(v, q, itx) do { CV_DECODE(itx, k0, n0, s0); (void)n0; cv_load(v, q, W, N, k0, s0, has ? ksc + k0 + lane : W, lane); } while (0)
#define CV_ST(v, q, itx, n) do { CV_DECODE(itx, k0, n0, s0); (void)s0; cv_store<F8>(v, (has ? q : 1.f) * (F8 ? F8_SW : 1.f), K, WT, scr, k0, n0, lane); } while (0)
    f32x4 v0[8], v1[8], v2[8], v3[8]; float q0, q1, q2, q3;
    CV_LD(v0, q0, it); CV_LD(v1, q1, it + 8); CV_LD(v2, q2, it + 16);
#pragma unroll
    for (int j = 0; j < 16; j += 4) {
        CV_LD(v3, q3, it + 24);
        CV_ST(v0, q0, it, 27);
        if (j + 4 < 16) { CV_LD(v0, q0, it + 32); CV_ST(v1, q1, it + 8, 27); CV_LD(v1, q1, it + 40); CV_ST(v2, q2, it + 16, 27); CV_LD(v2, q2, it + 48); CV_ST(v3, q3, it + 24, 27); }
        else { CV_ST(v1, q1, it + 8, 18); CV_ST(v2, q2, it + 16, 9); CV_ST(v3, q3, it + 24, 0); }
        it += 32;
    }
#undef CV_DECODE
#undef CV_LD
#undef CV_ST
}
__device__ __forceinline__ void h8_item(int i, unsigned char* ws, int wave, int lane) {
    const bf16_t* hp = (const bf16_t*)(ws + WS_H) + ((size_t)i * 64 + wave * 8) * D_MODEL + lane * 8; unsigned char* op = ws + WS_H8 + ((size_t)i * 64 + wave * 8) * D_MODEL + lane * 8;
#pragma unroll 2
    for (int r = 0; r < 8; ++r) { u32x4 w[8];
#pragma unroll
        for (int j = 0; j < 8; ++j) w[j] = *(const GAS u32x4*)(hp + (size_t)r * D_MODEL + j * 512);
#pragma unroll
        for (int j = 0; j < 8; ++j) { f32x4 a, b2; pg8::unpack8(w[j], a, b2); a = a * F8_SA; b2 = b2 * F8_SA;
            *(GAS u32x2*)(op + (size_t)r * D_MODEL + j * 512) = (u32x2){pk_fp8x4(a[0], a[1], a[2], a[3]), pk_fp8x4(b2[0], b2[1], b2[2], b2[3])}; } }
}
constexpr int CV_WIN8 = (D_MODEL / 64) * (2 * D_MODEL / 32) / 128, CV_H8 = M_TOK / 64, CV_ALL = CV_CHUNKS + CV_WIN8 + CV_H8;
static_assert(CV_ALL == 1160, "memory-bound queue items");
__device__ __forceinline__ void conv_chunk(int c, unsigned char* ws, LAS float* scr, int wave, int lane) {
    if (c >= CV_CHUNKS + CV_WIN8) { h8_item(c - CV_CHUNKS - CV_WIN8, ws, wave, lane); return; }
    if (c >= CV_CHUNKS) { conv_body<true>(c - CV_CHUNKS, AIN(I_WIN), nullptr, (bf16_t*)(ws + WS_WIN8), D_MODEL, IN_TOTAL, 2, scr, wave, lane, 2 * D_MODEL); return; }
    const float* W; const float* ksc = nullptr; bf16_t* WT; int K, N, gu = 0; bool f8 = false;
    if (c < CV_GU) { W = AIN(I_WGU); ksc = AIN(I_GFFN); WT = (bf16_t*)(ws + WS_WGU); K = D_MODEL; N = 2 * D_FF; gu = 1; }
    else if ((c -= CV_GU) < CV_DOWN) { W = AIN(I_WDOWN); WT = (bf16_t*)(ws + WS_WDOWN); K = D_FF; N = D_MODEL; }
    else if ((c -= CV_DOWN) < 4 * CV_SQ) { const int m = c / CV_SQ; c -= m * CV_SQ; W = AIN(m < 3 ? I_WA + m : I_WPG); if (m == 3) { ksc = AIN(I_GPLE); f8 = true; } WT = (bf16_t*)(ws + WS_WA + (size_t)m * (WS_WB - WS_WA)); K = D_MODEL; N = D_MODEL; }
    else { c -= 4 * CV_SQ; W = AIN(I_WPP); WT = (bf16_t*)(ws + WS_WPP); K = PLE_DIM; N = D_MODEL; }
    if (f8) conv_body<true>(c, W, ksc, WT, K, N, gu, scr, wave, lane);
    else conv_body<false>(c, W, ksc, WT, K, N, gu, scr, wave, lane);
}
static_assert(WS_WB - WS_WA == WS_WO - WS_WB && WS_WO - WS_WB == WS_WPG - WS_WO && I_WB == I_WA + 1 && I_WO == I_WA + 2, "the four square weights are addressed by index");
__global__ void __launch_bounds__(NWAVES * 64, 2) mk_fwd(Args args) {
    extern __shared__ __attribute__((aligned(16))) unsigned char lds_raw[];
    LAS unsigned char* lds = (LAS unsigned char*)lds_raw;
    volatile LAS unsigned* MISC = (volatile LAS unsigned*)(lds + MISC_OFF);
    const int wave = __builtin_amdgcn_readfirstlane((int)threadIdx.x >> 6);
#define LANE_HERE() int lane = lane_id(); asm volatile("" : "+v"(lane)); const int tid = wave * 64 + lane; (void)tid;
    const int G = gridDim.x; const int bx = blockIdx.x; const int vcu = (G % 8 == 0) ? (bx % 8) * (G / 8) + bx / 8 : bx;
    unsigned char* ws = args.ws;
    unsigned* ctl = (unsigned*)(ws + WS_CTL);
    for (int u = threadIdx.x; u < (LDS_BYTES - LDSCTL_OFF) / 4; u += NWAVES * 64) ((LAS unsigned*)(lds + LDSCTL_OFF))[u] = 0u;
    __syncthreads();
    const int lo = args.ph_lo, hi = args.ph_hi;
    XcdBarrier bar; bar.bar = ctl + CW_BAR; bar.x = 0; bar.st = nullptr;
    if (hi - lo > 1) bar = xcd_barrier_post(ctl + CW_BAR, MISC + 8);
#ifndef PHASE_MASK
#define PHASE_MASK 0x3ff
#endif
#define IN(k) ((((PHASE_MASK) >> (k)) & 1) && lo <= (k) && (k) < hi)
#define BOTH(k) (IN(k) && IN((k) + 1))
#ifndef REP_MASK
#define REP_MASK 0
#endif
#define NREP(k) ((((REP_MASK) >> (k)) & 1) ? 2 : 1)
#define WIN ((bf16_t*)(ws + WS_WIN))
#define WGU ((bf16_t*)(ws + WS_WGU))
#define WDOWN ((bf16_t*)(ws + WS_WDOWN))
#define WA ((bf16_t*)(ws + WS_WA))
#define WB ((bf16_t*)(ws + WS_WB))
#define WO ((bf16_t*)(ws + WS_WO))
#define WPG ((bf16_t*)(ws + WS_WPG))
#define WPP ((bf16_t*)(ws + WS_WPP))
#define HB ((bf16_t*)(ws + WS_H))
#define PB ((bf16_t*)(ws + WS_PB))
#define STATV ((float*)(ws + WS_STATV))
#define STAT1 ((float*)(ws + WS_STAT1))
#define STAT2 ((float*)(ws + WS_STAT2))
#define STAT3 ((float*)(ws + WS_STAT3))

    if (IN(0)) {
        LANE_HERE();
        LAS float* scr = (LAS float*)(lds + RING_OFF + wave * 16384);
#pragma unroll 1
        for (int rep = 0; rep < NREP(0); ++rep) {
        const int gw = vcu * NWAVES + wave, NGW = G * NWAVES; int base = 0;
        p0_matrix<2>(AIN(I_WIN), D_MODEL, IN_TOTAL, WIN, nullptr, scr, gw, NGW, base, lane, (bf16_t*)(ws + WS_WIN8));
        const float* gm = AIN(I_GMIX);
        for (int m = gw; m < M_TOK; m += NGW) {
            const GAS f32x4* xr = (const GAS f32x4*)(AIN(I_X) + (size_t)m * D_MODEL) + lane;
            f32x4 v[16]; float s = 0.f;
#pragma unroll
            for (int j = 0; j < 16; ++j) { v[j] = __builtin_nontemporal_load(xr + 64 * j); s += pg8::hsq4(v[j]); }
            const float rstd = rsqrtf(wave_sum(s) * (1.f / D_MODEL) + RMS_EPS);
            GAS u32x2* o8 = (GAS u32x2*)(HB + (size_t)m * D_MODEL) + lane;
#pragma unroll
            for (int j = 0; j < 16; ++j) { const f32x4 gv = *((const GAS f32x4*)gm + lane + 64 * j); u32x2 w; const f32x4 hv = v[j] * rstd * gv;
                w.x = cvt_pk_bf16(hv[0], hv[1]); w.y = cvt_pk_bf16(hv[2], hv[3]); o8[64 * j] = w; }
        }
        { const size_t n4 = (size_t)M_TOK * PLE_DIM / 4; const GAS f32x4* src = (const GAS f32x4*)AIN(I_P); GAS u32x2* dst = (GAS u32x2*)PB;
          for (size_t i = (size_t)gw * 64 + lane; i < n4; i += (size_t)NGW * 64) { const f32x4 v = __builtin_nontemporal_load(src + i); u32x2 w; w.x = cvt_pk_bf16(v[0], v[1]); w.y = cvt_pk_bf16(v[2], v[3]); dst[i] = w; } }
        }
        if (BOTH(0)) xcd_barrier(bar, wave);
    }
    if (IN(1)) {
        pg8::Gemm g{HB, WIN, HB, WIN, M_TOK, 5 * D_MODEL, D_MODEL, D_MODEL, D_MODEL / 64}; pg8::StaticOrder S; S.init(M_TOK, 5 * D_MODEL, G, bx);
        pg8::EpiProj E{(bf16_t*)(ws + WS_ACT), STATV, ctl + CW_KN};
#ifdef PROBE_EPI
        { pg8::EpiProbe<PROBE_EPI> EP{(bf16_t*)(ws + WS_ACT)}; pg8::gemm_phase<pg8::EpiProbe<PROBE_EPI>, pg8::StaticOrder, true, true>(lds + RING_OFF, g, S, EP, wave); }
#endif
#pragma unroll 1
        for (int rep = 0; rep < NREP(1); ++rep)
        pg8::gemm_phase<pg8::EpiProj, pg8::StaticOrder, true, true>(lds + RING_OFF, g, S, E, wave);
        if (BOTH(1)) xcd_barrier(bar, wave);
    }
    if (IN(2)) {
        LANE_HERE();
        bf16_t* GU = (bf16_t*)(ws + WS_GU); const bf16_t* GV = (const bf16_t*)(ws + WS_GV);
        constexpr int TST = 272;
        LAS unsigned char* Tl = lds; LAS unsigned char* Wl = lds + 65536; LAS f32x2* stl = (LAS f32x2*)(lds + 65536 + 128 * TST);
        const int tvb = (int)(uintptr_t)(lds) + att::v_rd_base(lane) + (wave & 3) * 512 + (wave >> 2) * 16384;
        const int r32 = lane & 31, hi5 = lane >> 5;
        int cur_g = -1;
#pragma unroll 1
        for (int rep = 0; rep < NREP(2); ++rep)
#pragma unroll 1
        for (int ui = 0; ui * G + vcu < (M_TOK / CHUNK) * GROUPS; ++ui) {
            const int uid = ui * G + vcu, gq = (G % 16 == 0) ? (vcu & 15) : (uid & 15), cbk = (G % 16 == 0) ? ((vcu >> 4) + (G >> 4) * ui) : (uid >> 4); const size_t R0 = (size_t)cbk * CHUNK;
            bf16_t* YO = (NREP(2) == 2 && rep == 0) ? HB : GU;
            f32x4 sp[8];
            { const f32x4* p = (const f32x4*)(STATV + (R0 + (tid >> 2)) * 128 + (tid & 3) * 32);
#pragma unroll
              for (int i = 0; i < 8; ++i) sp[i] = p[i]; }
            u32x4 gvw[8];
            const int c8 = (tid & 31) * 8;
#pragma unroll
            for (int i = 0; i < 8; ++i) gvw[i] = *(const u32x4*)(GV + (R0 + ((i * 512 + tid) >> 5)) * D_MODEL + gq * 256 + c8);
            u32x2 guw[4][4];
#pragma unroll
            for (int j = 0; j < 4; ++j)
#pragma unroll
                for (int q4 = 0; q4 < 4; ++q4) guw[j][q4] = *(const u32x2*)(GU + (R0 + 32 * j + r32) * D_MODEL + gq * 256 + 32 * wave + 4 * hi5 + 8 * q4);
            const float* lg = AIN(I_LNVG) + gq * 256 + c8; const float* lb = AIN(I_LNVB) + gq * 256 + c8;
            const f32x4 g0 = *(const f32x4*)lg, g1 = *(const f32x4*)(lg + 4), b0 = *(const f32x4*)lb, b1 = *(const f32x4*)(lb + 4);
            if (gq != cur_g) {
                __syncthreads();
                const float* Wg = AIN(I_WS) + (size_t)gq * CHUNK * CHUNK;
#pragma unroll
                for (int i = 0; i < 8; ++i) { const int idx = i * 512 + tid, t = idx >> 5, s4 = (idx & 31) * 4; const f32x4 v = *(const f32x4*)(Wg + t * CHUNK + s4);
                    u32x2 w; w.x = cvt_pk_bf16(s4 + 0 <= t ? v[0] : 0.f, s4 + 1 <= t ? v[1] : 0.f); w.y = cvt_pk_bf16(s4 + 2 <= t ? v[2] : 0.f, s4 + 3 <= t ? v[3] : 0.f);
                    *(LAS u32x2*)(Wl + t * TST + s4 * 2) = w; }
                cur_g = gq;
            }
            { float sm = 0.f, sq = 0.f;
#pragma unroll
              for (int i = 0; i < 8; ++i) { sm += sp[i][0] + sp[i][2]; sq += sp[i][1] + sp[i][3]; }
              sm += swz_xor<1>(sm); sm += swz_xor<2>(sm); sq += swz_xor<1>(sq); sq += swz_xor<2>(sq);
              const float mean = sm * (1.f / D_MODEL), var = sq * (1.f / D_MODEL) - mean * mean;
              if ((tid & 3) == 0) stl[tid >> 2] = (f32x2){mean, rsqrtf(var + LN_EPS)}; }
            __syncthreads();
#pragma unroll
            for (int i = 0; i < 8; ++i) { const int sr = (i * 512 + tid) >> 5; f32x4 v0, v1; pg8::unpack8(gvw[i], v0, v1); const f32x2 st = stl[sr];
                v0 = (v0 - st.x) * st.y * g0 + b0; v1 = (v1 - st.x) * st.y * g1 + b1;
                const int sk = sr & 63, kk = (sk & ~0xC) | ((sk & 4) << 1) | ((sk & 8) >> 1), cc = c8 & 127;
                *(LAS u32x4*)(Tl + ((sr >> 6) * 2 + (c8 >> 7)) * 16384 + ((kk >> 3) * 4 + (cc >> 5)) * 512 + ((kk & 7) * 32 + (cc & 31)) * 2) = pg8::pack8(v0, v1); }
            __syncthreads();
            f32x16 acc[4];
#pragma unroll
            for (int j = 0; j < 4; ++j) acc[j] = (f32x16){0.f, 0.f, 0.f, 0.f, 0.f, 0.f, 0.f, 0.f, 0.f, 0.f, 0.f, 0.f, 0.f, 0.f, 0.f, 0.f};
#pragma unroll
            for (int ks = 0; ks < 8; ++ks) {
                s16x4 tl_, th_;
                switch (ks) {
                    case 0: tl_ = att::tr_read<0>(tvb); th_ = att::tr_read<2048>(tvb); break;
                    case 1: tl_ = att::tr_read<4096>(tvb); th_ = att::tr_read<6144>(tvb); break;
                    case 2: tl_ = att::tr_read<8192>(tvb); th_ = att::tr_read<10240>(tvb); break;
                    case 3: tl_ = att::tr_read<12288>(tvb); th_ = att::tr_read<14336>(tvb); break;
                    case 4: tl_ = att::tr_read<32768>(tvb); th_ = att::tr_read<34816>(tvb); break;
                    case 5: tl_ = att::tr_read<36864>(tvb); th_ = att::tr_read<38912>(tvb); break;
                    case 6: tl_ = att::tr_read<40960>(tvb); th_ = att::tr_read<43008>(tvb); break;
                    default: tl_ = att::tr_read<45056>(tvb); th_ = att::tr_read<47104>(tvb); break;
                }
                asm volatile("s_waitcnt lgkmcnt(0)" ::: "memory"); __builtin_amdgcn_sched_barrier(0);
                const bf16x8 a = (bf16x8){tl_[0], tl_[1], tl_[2], tl_[3], th_[0], th_[1], th_[2], th_[3]};
#pragma unroll
                for (int j = 0; j < 4; ++j) if (16 * ks <= 32 * j + 31) { const bf16x8 bw = *(const LAS bf16x8*)(Wl + (32 * j + r32) * TST + (16 * ks + 8 * hi5) * 2);
                    acc[j] = __builtin_amdgcn_mfma_f32_32x32x16_bf16(a, bw, acc[j], 0, 0, 0); } }
            const float* bsg = AIN(I_BS) + gq * CHUNK;
#pragma unroll
            for (int j = 0; j < 4; ++j) { const int t = 32 * j + r32; const float bsv = bsg[t]; bf16_t* yp = YO + (R0 + t) * D_MODEL + gq * 256 + 32 * wave + 4 * hi5;
#pragma unroll
                for (int q4 = 0; q4 < 4; ++q4) { const u32x2 w = guw[j][q4]; const f32x2 ga = pg8::gelu_pk((f32x2){bflo(w.x), bfhi(w.x)}), gb = pg8::gelu_pk((f32x2){bflo(w.y), bfhi(w.y)});
                    u32x2 o; o.x = cvt_pk_bf16(ga.x * (acc[j][4 * q4 + 0] + bsv), ga.y * (acc[j][4 * q4 + 1] + bsv)); o.y = cvt_pk_bf16(gb.x * (acc[j][4 * q4 + 2] + bsv), gb.y * (acc[j][4 * q4 + 3] + bsv));
                    *(u32x2*)(yp + 8 * q4) = o; } }
        }
        __syncthreads();
    }
    if (IN(3)) {
        LANE_HERE();
        float lam;
        { const float a = wave_sum(AIN(I_LQ1)[lane] * AIN(I_LK1)[lane] + AIN(I_LQ1)[lane + 64] * AIN(I_LK1)[lane + 64]);
          const float c = wave_sum(AIN(I_LQ2)[lane] * AIN(I_LK2)[lane] + AIN(I_LQ2)[lane + 64] * AIN(I_LK2)[lane + 64]);
          lam = sgpr_f(__expf(a) - __expf(c) + LAM_INIT); }
        const bf16_t* Qp = (const bf16_t*)(ws + WS_Q); const bf16_t* Kp = (const bf16_t*)(ws + WS_K); const bf16_t* Vp = (const bf16_t*)(ws + WS_V);
        LAS int* qslot = (LAS int*)(lds + ATT_Q_OFF);
#pragma unroll 1
        for (int rep = 0; rep < NREP(3); ++rep) {
        unsigned* qheads = ctl + CW_ATTQ + rep * 512;
        if (wave == 0 && lane_id() == 0) qslot[2] = 0;
        bool have = false;
#pragma unroll 1
        for (;;) {
            if (!have && wave == 0 && lane_id() == 0) att::att_pop(qslot, qheads);
            ATT_BAR();
            const int item = __builtin_amdgcn_readfirstlane(*qslot);
            if (item < 0) break;
            int l2 = lane_id(); asm volatile("" : "+v"(l2));
            if (item >= 2048) { __builtin_amdgcn_s_waitcnt(0); ATT_BAR(); conv_chunk(item - 2048, ws, (LAS float*)(lds + RING_OFF + wave * 16384), wave, l2); have = false; continue; }
            const int b = item >> 10, h = (item >> 6) & 15, qbk = item & 63;
            const float slope2 = sgpr_f(exp2f(-0.5f * (float)(h + 1)) * 1.4426950408889634f);
#ifdef ATT_PROBE_VAR
            if (NREP(3) == 2 && rep == 0) att::attn_unit<ATT_PROBE_VAR>(lds + RING_OFF, (LAS float*)(lds + ATT_SCR_OFF), Qp, Kp, Vp, (bf16_t*)(ws + WS_H), b, h, qbk, lam, slope2, AIN(I_SUBLN), ctl + CW_KN, wave, lane, qslot, qheads);
            else
#endif
            att::attn_unit<0>(lds + RING_OFF, (LAS float*)(lds + ATT_SCR_OFF), Qp, Kp, Vp, (bf16_t*)(ws + ((NREP(3) == 2 && rep == 0) ? WS_H : WS_Q)), b, h, qbk, lam, slope2, AIN(I_SUBLN), ctl + CW_KN, wave, l2, qslot, qheads);
            have = true;
        }
        }
        if (BOTH(3)) xcd_barrier(bar, wave);
    }
    if (IN(4)) {
        { const bf16_t* A8 = (const bf16_t*)(ws + WS_H8); const bf16_t* B8 = (const bf16_t*)(ws + WS_WIN8);
          pg8::Gemm g8{A8, B8, A8, B8, M_TOK, 2 * D_MODEL, D_MODEL / 2, D_MODEL / 2, D_MODEL / 128}; pg8::StaticOrder S8; S8.init(M_TOK, 2 * D_MODEL, G, bx);
          pg8::EpiGates E8{(bf16_t*)(ws + WS_ACT), AIN(I_BGATE)};
#if PROBE_NULLEPI & 4
          { pg8::EpiNull EN; pg8::gemm_phase<pg8::EpiNull, pg8::StaticOrder, true, true, true>(lds + RING_OFF, g8, S8, EN, wave); }
#endif
#pragma unroll 1
          for (int rep = 0; rep < NREP(11); ++rep)
          pg8::gemm_phase<pg8::EpiGates, pg8::StaticOrder, true, true, true>(lds + RING_OFF, g8, S8, E8, wave); }
        if (hi - lo > 1) xcd_barrier(bar, wave);
        { pg8::Gemm g{(const bf16_t*)(ws + WS_GU), WA, (const bf16_t*)(ws + WS_Q), WB, M_TOK, D_MODEL, 2 * D_MODEL, D_MODEL, D_MODEL / 64}; pg8::PanelOrder<2> S; S.init(M_TOK, G, bx);
          pg8::EpiMerge E{(const bf16_t*)(ws + WS_SA), (const bf16_t*)(ws + WS_SB), (bf16_t*)(ws + WS_MERGED)};
#if PROBE_NULLEPI & 1
          { pg8::EpiNull EN; pg8::gemm_phase<pg8::EpiNull, pg8::PanelOrder<2>, true, true>(lds + RING_OFF, g, S, EN, wave); }
#endif
#pragma unroll 1
          for (int rep = 0; rep < NREP(4); ++rep)
          pg8::gemm_phase<pg8::EpiMerge, pg8::PanelOrder<2>, true, true>(lds + RING_OFF, g, S, E, wave); }
        if (BOTH(4)) xcd_barrier(bar, wave);
    }
    if (IN(5)) {
        pg8::Gemm g{(const bf16_t*)(ws + WS_MERGED), WO, (const bf16_t*)(ws + WS_MERGED), WO, M_TOK, D_MODEL, D_MODEL, D_MODEL, D_MODEL / 64}; pg8::StaticOrder S; S.init(M_TOK, D_MODEL, G, bx);
        pg8::EpiResF32 E{AIN(I_X), HB, STAT1};
#if PROBE_NULLEPI & 2
        { pg8::EpiNull EN; pg8::gemm_phase<pg8::EpiNull, pg8::StaticOrder, true, true>(lds + RING_OFF, g, S, EN, wave); }
#endif
#pragma unroll 1
        for (int rep = 0; rep < NREP(5); ++rep)
        pg8::gemm_phase<pg8::EpiResF32, pg8::StaticOrder, true, true>(lds + RING_OFF, g, S, E, wave);
        if (BOTH(5)) xcd_barrier(bar, wave);
    }
    if (IN(6)) {
        pg8::Gemm g{HB, WGU, HB, WGU, M_TOK, 2 * D_FF, D_MODEL, D_MODEL, D_MODEL / 64}; pg8::StaticOrder S; S.init(M_TOK, 2 * D_FF, G, bx);
        pg8::Unit u0; const bool any = S.next(0, u0); { LANE_HERE(); if (any) fill_row_scale((LAS float*)(lds + RS_OFF), STAT1, u0.pm, wave, lane); }
        pg8::EpiSwiglu E{pg8::RowScale{(const LAS float*)(lds + RS_OFF), any ? u0.pm : -1, STAT1}, (bf16_t*)(ws + WS_HID)};
#pragma unroll 1
        for (int rep = 0; rep < NREP(6); ++rep)
        pg8::gemm_phase<pg8::EpiSwiglu, pg8::StaticOrder, true, true>(lds + RING_OFF, g, S, E, wave);
        { const int nwg6 = (M_TOK / 256) * (2 * D_FF / 256), rem = nwg6 % G, nw = rem ? G - rem : G, me = rem ? bx - rem : bx;
          if (me >= 0) { pg8::Gemm g2{PB, WPP, PB, WPP, M_TOK, D_MODEL, PLE_DIM, PLE_DIM, PLE_DIM / 64}; pg8::StaticOrder S2; S2.init(M_TOK, D_MODEL, nw, me);
            pg8::EpiPlain E2{(bf16_t*)(ws + WS_PP), D_MODEL};
#pragma unroll 1
            for (int rep = 0; rep < NREP(10); ++rep)
            pg8::gemm_phase<pg8::EpiPlain, pg8::StaticOrder, true, true>(lds + RING_OFF, g2, S2, E2, wave); } }
        if (BOTH(6)) xcd_barrier(bar, wave);
    }
    if (IN(7)) {
        pg8::Gemm g{(const bf16_t*)(ws + WS_HID), WDOWN, (const bf16_t*)(ws + WS_HID), WDOWN, M_TOK, D_MODEL, D_FF, D_FF, D_FF / 64}; pg8::PanelOrder<2> S; S.init(M_TOK, G, bx);
#pragma unroll 1
        for (int rep = 0; rep < NREP(7); ++rep) {
        pg8::EpiResBf E{HB, STAT2, (NREP(7) == 2 && rep == 0) ? (bf16_t*)(ws + WS_X3) : HB, ws + WS_X8};
        pg8::gemm_phase<pg8::EpiResBf, pg8::PanelOrder<2>, true, true>(lds + RING_OFF, g, S, E, wave); }
        if (BOTH(7)) xcd_barrier(bar, wave);
    }
    if (IN(8)) {
        const bf16_t* A8 = (const bf16_t*)(ws + WS_X8);
        pg8::Gemm g{A8, WPG, A8, WPG, M_TOK, D_MODEL, D_MODEL / 2, D_MODEL / 2, D_MODEL / 128}; pg8::StaticOrder S; S.init(M_TOK, D_MODEL, G, bx);
        pg8::Unit u0; const bool any = S.next(0, u0); { LANE_HERE(); if (any) fill_row_scale((LAS float*)(lds + RS_OFF), STAT2, u0.pm, wave, lane); }
        pg8::EpiPle E{pg8::RowScale{(const LAS float*)(lds + RS_OFF), any ? u0.pm : -1, STAT2}, HB, (const bf16_t*)(ws + WS_PP), (bf16_t*)(ws + WS_X3), STAT3};
#pragma unroll 1
        for (int rep = 0; rep < NREP(8); ++rep)
        pg8::gemm_phase<pg8::EpiPle, pg8::StaticOrder, true, true, true>(lds + RING_OFF, g, S, E, wave);
        if (BOTH(8)) xcd_barrier(bar, wave);
    }
    if (IN(9)) {
        LANE_HERE();
        const int gw = vcu * NWAVES + wave, NGW = G * NWAVES; const float* gf = AIN(I_GFINAL);
        const unsigned tmo = __hip_atomic_load(ctl + CW_BAR + XB_TMO, __ATOMIC_RELAXED, __HIP_MEMORY_SCOPE_AGENT);
        for (int m = gw; m < M_TOK; m += NGW) {
            float s = STAT3[(size_t)m * 64 + lane]; s = wave_sum(s);
            float rstd = rsqrtf(s * (1.f / D_MODEL) + RMS_EPS); if (tmo) rstd = __builtin_nanf("");
            GAS f32x4* xr = (GAS f32x4*)(args.out + (size_t)m * D_MODEL) + lane; const GAS u32x2* x3 = (const GAS u32x2*)((const bf16_t*)(ws + WS_X3) + (size_t)m * D_MODEL) + lane;
#pragma unroll
            for (int j = 0; j < 16; ++j) { const u32x2 w = x3[64 * j]; const f32x4 v = (f32x4){bflo(w.x), bfhi(w.x), bflo(w.y), bfhi(w.y)}; const f32x4 gv = *((const GAS f32x4*)gf + lane + 64 * j); xr[64 * j] = v * rstd * gv; }
        }
    }
#undef IN
#undef BOTH
}

extern "C" void kernel_launch(void* const* d_in, const int* in_sizes, int n_in, void* d_out, int out_size, void* d_ws, size_t ws_size, hipStream_t stream) {
    static int grid = 0;
    if (grid == 0) {
        if (n_in != 24 || out_size != M_TOK * D_MODEL || ws_size < WS_END) { fprintf(stderr, "kernel_launch: unexpected shapes (n_in %d, out %d, ws %zu < %zu)\n", n_in, out_size, ws_size, (size_t)WS_END); grid = -1; return; }
        int dev = 0, cus = 0, per_cu = 0;
        if (hipGetDevice(&dev) != hipSuccess || hipDeviceGetAttribute(&cus, hipDeviceAttributeMultiprocessorCount, dev) != hipSuccess) { grid = -1; return; }
        if (hipFuncSetAttribute((const void*)mk_fwd, hipFuncAttributeMaxDynamicSharedMemorySize, LDS_BYTES) != hipSuccess) { fprintf(stderr, "kernel_launch: hipFuncSetAttribute failed\n"); grid = -1; return; }
        if (hipOccupancyMaxActiveBlocksPerMultiprocessor(&per_cu, (const void*)mk_fwd, NWAVES * 64, LDS_BYTES) != hipSuccess || per_cu < 1) { fprintf(stderr, "kernel_launch: occupancy query says %d\n", per_cu); }
        (void)hipGetLastError();
        grid = cus;
    }
    if (grid < 0) return;
    (void)hipMemsetAsync((char*)d_ws + WS_CTL, 0, CTL_ZERO_BYTES, stream);
    Args a{};
    for (int i = 0; i < 24; ++i) a.in[i] = (const float*)d_in[i];
    a.out = (float*)d_out; a.ws = (unsigned char*)d_ws;
#if DBG_CHECK
    for (int k = 0; k < N_PHASES; ++k) { a.ph_lo = k; a.ph_hi = k + 1; hipLaunchKernelGGL(mk_fwd, dim3(grid), dim3(NWAVES * 64), LDS_BYTES, stream, a); }
#else
    a.ph_lo = 0; a.ph_hi = N_PHASES;
    hipLaunchKernelGGL(mk_fwd, dim3(grid), dim3(NWAVES * 64), LDS_BYTES, stream, a);
#endif
}
```
